# Optimizing an MI355X kernel written in HIP

```python
import math, functools
import jax, jax.numpy as jnp
from jax import lax
import numpy as np

D_MODEL = 1024
BATCH = 32
SEQ = 256
DEPTH = 2
DEC_BATCH = 8
DEC_SEQ = 2048
PAST_LEN = 256

GRID_W = 64
HEAD_DIM = 64
N_HEADS = 8
N_KV_HEADS = 2
GQA_GROUP = N_HEADS // N_KV_HEADS
ATTN_WIDTH = N_HEADS * HEAD_DIM
KV_WIDTH = N_KV_HEADS * HEAD_DIM
WINDOW = 128
BLOCK = 128
ATTN_SCALE = HEAD_DIM ** -0.5
ROPE_BASE = 10000.0
NEG_INF = -1e30
FNET_HEADS = 4
FNET_HEAD_DIM = 64
FNET_WIDTH = FNET_HEADS * FNET_HEAD_DIM
SSM_WIDTH = 256
SSM_GROUP = 16
SSM_GROUPS = SSM_WIDTH // SSM_GROUP
SSM_STATE = 64
MIX_WIDTH = ATTN_WIDTH + FNET_WIDTH + SSM_WIDTH
Q_END = ATTN_WIDTH
K_END = Q_END + KV_WIDTH
V_END = K_END + KV_WIDTH
F_END = V_END + FNET_WIDTH
S_END = F_END + SSM_WIDTH
IN_WIDTH = S_END
D_FF = 2816
N_MOD = 9
NORM_EPS = 1e-6

kernel_name = 'hymba_style_fnet_s5_diffusion_step'


def rms_norm(x, g):
    xf = x.astype(jnp.float32)
    y = xf * lax.rsqrt(jnp.mean(xf * xf, axis=-1, keepdims=True) + NORM_EPS)
    return (y * g.astype(jnp.float32)).astype(x.dtype)


def modulate(h, shift, scale):
    return h * (1.0 + scale[..., None, :]) + shift[..., None, :]


def swiglu(h, w1, w3, w2):
    return (jax.nn.silu(h @ w1) * (h @ w3)) @ w2


def axial_rope(x):
    L = x.shape[1]
    rows = L // GRID_W
    row = jnp.repeat(jnp.arange(rows, dtype=jnp.float32), GRID_W)
    col = jnp.tile(jnp.arange(GRID_W, dtype=jnp.float32), rows)
    half = HEAD_DIM // 2
    quarter = half // 2
    inv_freq = 1.0 / (ROPE_BASE ** (jnp.arange(quarter, dtype=jnp.float32) * 2.0 / half))
    xf = x.astype(jnp.float32)

    def rotate(xh, pos):
        ang = pos[:, None] * inv_freq[None, :]
        cos = jnp.cos(ang)[None, :, None, :]
        sin = jnp.sin(ang)[None, :, None, :]
        x1, x2 = xh[..., :quarter], xh[..., quarter:]
        return jnp.concatenate([x1 * cos - x2 * sin, x1 * sin + x2 * cos], axis=-1)

    out = jnp.concatenate([rotate(xf[..., :half], row), rotate(xf[..., half:], col)], axis=-1)
    return out.astype(x.dtype)


def attn_heads(u, q_g, k_g):
    B, L, _ = u.shape
    q = u[..., :Q_END].reshape(B, L, N_HEADS, HEAD_DIM)
    k = u[..., Q_END:K_END].reshape(B, L, N_KV_HEADS, HEAD_DIM)
    v = u[..., K_END:V_END].reshape(B, L, N_KV_HEADS, HEAD_DIM)
    return rms_norm(q, q_g), rms_norm(k, k_g), v


def sink_softmax(s, sink):
    sk = jnp.broadcast_to(sink.astype(jnp.float32).reshape(N_KV_HEADS, GQA_GROUP, 1, 1), s.shape[:-1] + (1,))
    return jax.nn.softmax(jnp.concatenate([sk, s], axis=-1), axis=-1)[..., 1:]


def context_attention(q, k, v, sink):
    B, C = q.shape[:2]
    nb = C // BLOCK
    qb = jnp.moveaxis(q.reshape(B, nb, BLOCK, N_KV_HEADS, GQA_GROUP, HEAD_DIM), 1, 0)
    kf = k.astype(jnp.float32)
    vf = v.astype(jnp.float32)

    def one_block(qblk):
        s = jnp.einsum('bqhgd,bkhd->bhgqk', qblk.astype(jnp.float32), kf) * ATTN_SCALE
        p = sink_softmax(s, sink)
        return jnp.einsum('bhgqk,bkhd->bqhgd', p, vf)

    o = lax.map(one_block, qb)
    return jnp.moveaxis(o, 0, 1).reshape(B, C, ATTN_WIDTH).astype(q.dtype)


def latent_attention(q, k, v, k_ctx, v_ctx, sink):
    B, L = q.shape[:2]
    nb = L // BLOCK
    span = BLOCK + 2 * WINDOW
    qb = jnp.moveaxis(q.reshape(B, nb, BLOCK, N_KV_HEADS, GQA_GROUP, HEAD_DIM), 1, 0)
    pad = ((0, 0), (WINDOW, WINDOW), (0, 0), (0, 0))
    kp = jnp.pad(k.astype(jnp.float32), pad)
    vp = jnp.pad(v.astype(jnp.float32), pad)
    kc = k_ctx.astype(jnp.float32)
    vc = v_ctx.astype(jnp.float32)
    C = kc.shape[1]
    rel = (jnp.arange(span)[None, :] - WINDOW) - jnp.arange(BLOCK)[:, None]
    in_window = jnp.abs(rel) <= WINDOW

    def one_block(args):
        n, qblk = args
        start = n * BLOCK
        kw = lax.dynamic_slice_in_dim(kp, start, span, axis=1)
        vw = lax.dynamic_slice_in_dim(vp, start, span, axis=1)
        kpos = start - WINDOW + jnp.arange(span)
        valid = in_window & ((kpos >= 0) & (kpos < L))[None, :]
        qf = qblk.astype(jnp.float32)
        s_loc = jnp.einsum('bqhgd,bkhd->bhgqk', qf, kw) * ATTN_SCALE
        s_loc = jnp.where(valid, s_loc, NEG_INF)
        s_ctx = jnp.einsum('bqhgd,bchd->bhgqc', qf, kc) * ATTN_SCALE
        p = sink_softmax(jnp.concatenate([s_ctx, s_loc], axis=-1), sink)
        return (jnp.einsum('bhgqc,bchd->bqhgd', p[..., :C], vc)
                + jnp.einsum('bhgqk,bkhd->bqhgd', p[..., C:], vw))

    o = lax.map(one_block, (jnp.arange(nb), qb))
    return jnp.moveaxis(o, 0, 1).reshape(B, L, ATTN_WIDTH).astype(q.dtype)


def fourier_mix(u, w_f):
    B, L, _ = u.shape
    uf = u.astype(jnp.float32).reshape(B, L, FNET_HEADS, FNET_HEAD_DIM)
    z = jnp.fft.fft2(uf, axes=(1, 3), norm='ortho').real
    return z.reshape(B, L, FNET_WIDTH).astype(u.dtype) @ w_f


def s5_scan(bu, lam_bar, h0):
    if h0 is not None:
        bu = bu.at[:, 0].add(lam_bar * h0)
    a = jnp.broadcast_to(lam_bar, bu.shape)

    def combine(e1, e2):
        return e1[0] * e2[0], e2[0] * e1[1] + e2[1]

    return lax.associative_scan(combine, (a, bu), axis=1)[1]


def s5_mixer(u, lp, h0, return_state):
    B, L, _ = u.shape
    ug = u.astype(jnp.float32).reshape(B, L, SSM_GROUPS, SSM_GROUP)
    y = lp['ssm_d'].astype(jnp.float32) * ug
    finals_re, finals_im = [], []
    for r in range(2):
        lam = lax.complex(lp['ssm_lambda_re'][r].astype(jnp.float32), lp['ssm_lambda_im'][r].astype(jnp.float32))
        bmat = lax.complex(lp['ssm_b_re'][r].astype(jnp.float32), lp['ssm_b_im'][r].astype(jnp.float32))
        step = jnp.exp(lp['ssm_log_step'][r].astype(jnp.float32))[:, None]
        lam_bar = jnp.exp(lam * step)
        b_bar = ((lam_bar - 1.0) / lam)[..., None] * bmat
        bu = jnp.einsum('blgh,gph->blgp', ug, b_bar)
        init = None if h0 is None else lax.complex(h0[0][:, r].astype(jnp.float32), h0[1][:, r].astype(jnp.float32))
        if r == 1:
            bu = jnp.flip(bu, axis=1)
        s = s5_scan(bu, lam_bar, init)
        if return_state:
            finals_re.append(s[:, -1].real)
            finals_im.append(s[:, -1].imag)
        if r == 1:
            s = jnp.flip(s, axis=1)
        y = (y + jnp.einsum('ghp,blgp->blgh', lp['ssm_c_re'][r].astype(jnp.float32), s.real)
             - jnp.einsum('ghp,blgp->blgh', lp['ssm_c_im'][r].astype(jnp.float32), s.imag))
    y = jax.nn.gelu(y.reshape(B, L, SSM_WIDTH))
    gl = y @ lp['ssm_w_glu'].astype(jnp.float32)
    out = gl[..., :SSM_WIDTH] * jax.nn.sigmoid(gl[..., SSM_WIDTH:])
    state = (jnp.stack(finals_re, axis=1), jnp.stack(finals_im, axis=1)) if return_state else None
    return out.astype(u.dtype), state


def context_mix(u, lp):
    q, k, v = attn_heads(u, lp['q_norm_g'], lp['k_norm_g'])
    a = context_attention(q, k, v, lp['attn_sink'])
    f = fourier_mix(u[..., V_END:F_END], lp['w_fnet'])
    s, (st_re, st_im) = s5_mixer(u[..., F_END:S_END], lp, None, True)
    return jnp.concatenate([a, f, s], axis=-1), (k, v, st_re, st_im)


def latent_mix(u, lp, k_ctx, v_ctx, h0_re, h0_im):
    q, k, v = attn_heads(u, lp['q_norm_g'], lp['k_norm_g'])
    q, k = axial_rope(q), axial_rope(k)
    a = latent_attention(q, k, v, k_ctx, v_ctx, lp['attn_sink'])
    f = fourier_mix(u[..., V_END:F_END], lp['w_fnet'])
    s, _ = s5_mixer(u[..., F_END:S_END], lp, (h0_re, h0_im), False)
    return jnp.concatenate([a, f, s], axis=-1), None


def layer_forward(x, cond, lp, mix_fn):
    m = jax.nn.silu(cond) @ lp['w_mod'] + lp['b_mod']
    sh1, sc1, g1, sh2, sc2, g2, sh3, sc3, g3 = jnp.split(m, N_MOD, axis=-1)
    h = modulate(rms_norm(x, lp['norm_g'][0]), sh1, sc1)
    x = x + 0.5 * g1[..., None, :] * swiglu(h, lp['ffn_w1'][0], lp['ffn_w3'][0], lp['ffn_w2'][0])
    h = modulate(rms_norm(x, lp['norm_g'][1]), sh2, sc2)
    mixed, extras = mix_fn(h @ lp['w_in'])
    x = x + g2[..., None, :] * (mixed @ lp['w_out'])
    h = modulate(rms_norm(x, lp['norm_g'][2]), sh3, sc3)
    x = x + 0.5 * g3[..., None, :] * swiglu(h, lp['ffn_w1'][1], lp['ffn_w3'][1], lp['ffn_w2'][1])
    return x, extras


def setup_inputs(seed: int = 0) -> dict:
    key = jax.random.key(seed)
    ks = jax.random.split(key, 29)

    def nrm(k, shape, s):
        return jax.random.normal(k, shape, jnp.float32) * s

    ssm_shape = (DEPTH, 2, SSM_GROUPS, SSM_STATE)
    n = jnp.arange(SSM_STATE, dtype=jnp.float32)
    return {
        'x_prompt': nrm(ks[0], (BATCH, SEQ, D_MODEL), 1.0),
        'x_sample': nrm(ks[1], (DEC_BATCH, DEC_SEQ, D_MODEL), 1.0),
        'cache_k': nrm(ks[2], (DEC_BATCH, DEPTH, PAST_LEN, N_KV_HEADS, HEAD_DIM), 1.0),
        'cache_v': nrm(ks[3], (DEC_BATCH, DEPTH, PAST_LEN, N_KV_HEADS, HEAD_DIM), 1.0),
        'state_ssm_re': nrm(ks[4], (DEC_BATCH, DEPTH, 2, SSM_GROUPS, SSM_STATE), 0.1),
        'state_ssm_im': nrm(ks[5], (DEC_BATCH, DEPTH, 2, SSM_GROUPS, SSM_STATE), 0.1),
        'c': nrm(ks[6], (DEC_BATCH, D_MODEL), 1.0),
        'c_ctx': nrm(ks[7], (D_MODEL,), 1.0),
        'w_mod': nrm(ks[8], (DEPTH, D_MODEL, N_MOD * D_MODEL), 0.5 * D_MODEL ** -0.5),
        'b_mod': nrm(ks[9], (DEPTH, N_MOD * D_MODEL), 0.01),
        'norm_g': 1.0 + nrm(ks[10], (DEPTH, 3, D_MODEL), 0.01),
        'ffn_w1': nrm(ks[11], (DEPTH, 2, D_MODEL, D_FF), D_MODEL ** -0.5),
        'ffn_w3': nrm(ks[12], (DEPTH, 2, D_MODEL, D_FF), D_MODEL ** -0.5),
        'ffn_w2': nrm(ks[13], (DEPTH, 2, D_FF, D_MODEL), D_FF ** -0.5),
        'w_in': nrm(ks[14], (DEPTH, D_MODEL, IN_WIDTH), D_MODEL ** -0.5),
        'w_out': nrm(ks[15], (DEPTH, MIX_WIDTH, D_MODEL), MIX_WIDTH ** -0.5),
        'q_norm_g': 1.0 + nrm(ks[16], (DEPTH, HEAD_DIM), 0.01),
        'k_norm_g': 1.0 + nrm(ks[17], (DEPTH, HEAD_DIM), 0.01),
        'attn_sink': nrm(ks[18], (DEPTH, N_HEADS), 0.5),
        'w_fnet': nrm(ks[19], (DEPTH, FNET_WIDTH, FNET_WIDTH), FNET_WIDTH ** -0.5),
        'ssm_lambda_re': -0.5 + nrm(ks[20], ssm_shape, 0.01),
        'ssm_lambda_im': math.pi * n + nrm(ks[21], ssm_shape, 0.01),
        'ssm_b_re': nrm(ks[22], (DEPTH, 2, SSM_GROUPS, SSM_STATE, SSM_GROUP), (2.0 * SSM_GROUP) ** -0.5),
        'ssm_b_im': nrm(ks[23], (DEPTH, 2, SSM_GROUPS, SSM_STATE, SSM_GROUP), (2.0 * SSM_GROUP) ** -0.5),
        'ssm_c_re': nrm(ks[24], (DEPTH, 2, SSM_GROUPS, SSM_GROUP, SSM_STATE), SSM_STATE ** -0.5),
        'ssm_c_im': nrm(ks[25], (DEPTH, 2, SSM_GROUPS, SSM_GROUP, SSM_STATE), SSM_STATE ** -0.5),
        'ssm_d': nrm(ks[26], (DEPTH, SSM_GROUPS, SSM_GROUP), 1.0),
        'ssm_log_step': jax.random.uniform(ks[27], (DEPTH, 2, SSM_GROUPS), jnp.float32, math.log(1e-3), math.log(1e-1)),
        'ssm_w_glu': nrm(ks[28], (DEPTH, SSM_WIDTH, 2 * SSM_WIDTH), SSM_WIDTH ** -0.5),
    }


def reference(x_prompt, x_sample, cache_k, cache_v, state_ssm_re, state_ssm_im, c, c_ctx,
              w_mod, b_mod, norm_g, ffn_w1, ffn_w3, ffn_w2, w_in, w_out, q_norm_g, k_norm_g,
              attn_sink, w_fnet, ssm_lambda_re, ssm_lambda_im, ssm_b_re, ssm_b_im, ssm_c_re,
              ssm_c_im, ssm_d, ssm_log_step, ssm_w_glu):
    y_prompt = x_prompt
    y_sample = x_sample
    ks, vs, sre, sim = [], [], [], []
    for l in range(DEPTH):
        lp = {
            'w_mod': w_mod[l], 'b_mod': b_mod[l], 'norm_g': norm_g[l],
            'ffn_w1': ffn_w1[l], 'ffn_w3': ffn_w3[l], 'ffn_w2': ffn_w2[l],
            'w_in': w_in[l], 'w_out': w_out[l],
            'q_norm_g': q_norm_g[l], 'k_norm_g': k_norm_g[l], 'attn_sink': attn_sink[l],
            'w_fnet': w_fnet[l],
            'ssm_lambda_re': ssm_lambda_re[l], 'ssm_lambda_im': ssm_lambda_im[l],
            'ssm_b_re': ssm_b_re[l], 'ssm_b_im': ssm_b_im[l],
            'ssm_c_re': ssm_c_re[l], 'ssm_c_im': ssm_c_im[l],
            'ssm_d': ssm_d[l], 'ssm_log_step': ssm_log_step[l], 'ssm_w_glu': ssm_w_glu[l],
        }
        y_prompt, (k_l, v_l, st_re, st_im) = layer_forward(
            y_prompt, c_ctx, lp, functools.partial(context_mix, lp=lp))
        ks.append(k_l)
        vs.append(v_l)
        sre.append(st_re)
        sim.append(st_im)
        y_sample, _ = layer_forward(
            y_sample, c, lp,
            functools.partial(latent_mix, lp=lp, k_ctx=cache_k[:, l], v_ctx=cache_v[:, l],
                              h0_re=state_ssm_re[:, l], h0_im=state_ssm_im[:, l]))
    new_cache_k = jnp.stack(ks, axis=1)
    new_cache_v = jnp.stack(vs, axis=1)
    new_state_ssm_re = jnp.stack(sre, axis=1)
    new_state_ssm_im = jnp.stack(sim, axis=1)
    return (y_prompt, y_sample, new_cache_k, new_cache_v, new_state_ssm_re, new_state_ssm_im)
```

```cpp
#include <hip/hip_runtime.h>
#include <hip/hip_cooperative_groups.h>
#include <cstdio>
#include <cstdint>
#include <cmath>
namespace cg = cooperative_groups;

#define LAS __attribute__((address_space(3)))
typedef unsigned short bf16_t;
typedef short bf16x8 __attribute__((ext_vector_type(8)));
typedef float f32x4 __attribute__((ext_vector_type(4)));
typedef float f32x2 __attribute__((ext_vector_type(2)));
typedef unsigned u32x4 __attribute__((ext_vector_type(4)));
typedef unsigned u32x2 __attribute__((ext_vector_type(2)));

constexpr int DM = 1024, FF = 2816, MC = 8192, MT = 24576;
constexpr int MIXW = 1280;
constexpr size_t O_CK = 25165824, O_CV = 27262976, O_SRE = 29360128, O_SIM = 29491200;
enum { I_XP = 0, I_XS, I_CK, I_CV, I_SRE, I_SIM, I_C, I_CCTX, I_WMOD, I_BMOD, I_NG, I_W1, I_W3, I_W2, I_WIN, I_WOUT, I_QG, I_KG, I_SINK, I_WF,
       I_LRE, I_LIM, I_BRE, I_BIM, I_CRE, I_CIM, I_SD, I_LS, I_GLU, N_IN };

constexpr size_t al(size_t x) { return (x + 255) & ~(size_t)255; }
constexpr size_t WS_MOD = 0;
constexpr size_t WS_PTAB = WS_MOD + al((size_t)2 * 9 * 9216 * 4);
constexpr size_t WS_KTAB = WS_PTAB + al((size_t)2 * 2 * 16 * 64 * 34 * 8);
constexpr size_t WS_G = WS_KTAB + al((size_t)2 * 16 * 2 * 32 * 256 * 4);
constexpr size_t WS_TW = WS_G, WS_WOFT = WS_G + (size_t)2 * 512 * 256 * 2, WS_ROPE = WS_WOFT + (size_t)2 * 1024 * 256 * 2, WS_TWID = WS_ROPE + 8192;
constexpr size_t WS_W13T = WS_G + al((size_t)2 * 256 * 1024 * 4);
constexpr size_t WS_W2T = WS_W13T + al((size_t)4 * 5632 * 1024 * 2);
constexpr size_t WS_WINT = WS_W2T + al((size_t)4 * 1024 * 2816 * 2);
constexpr size_t WS_WOUTT = WS_WINT + al((size_t)2 * 1280 * 1024 * 2);
constexpr size_t WS_WGLUT = WS_WOUTT + al((size_t)2 * 1024 * 1280 * 2);
constexpr size_t WS_DFTL = WS_WGLUT + al((size_t)2 * 512 * 256 * 2);
constexpr size_t WS_DFTC = WS_DFTL + al((size_t)4096 * 2048 * 2);
constexpr size_t WS_MTT = WS_DFTC + al((size_t)512 * 256 * 2);
constexpr size_t WS_WAT = WS_MTT + al((size_t)2 * 16 * 512 * 768 * 2);
constexpr size_t WS_KC = WS_WAT + al((size_t)2 * 16 * 256 * 512 * 2);
constexpr size_t WS_VTC = WS_KC + al((size_t)2 * 8 * 256 * 128 * 2);
constexpr size_t WS_XN = WS_VTC + al((size_t)2 * 8 * 2 * 64 * 256 * 2);
constexpr size_t WS_BIG = WS_XN + al((size_t)MT * 1024 * 2);
constexpr size_t WS_HID = WS_BIG;
constexpr size_t WS_MIX = WS_BIG;
constexpr size_t WS_KVRAW = WS_MIX + al((size_t)MT * 1280 * 2);
constexpr size_t WS_Y = WS_KVRAW;
constexpr size_t WS_KN = WS_KVRAW + al((size_t)MT * 256 * 2);
constexpr size_t WS_VT = WS_KN + al((size_t)MT * 128 * 2);
constexpr size_t WS_UT = WS_VT + al((size_t)MT * 128 * 2);
constexpr size_t WS_AC = WS_UT + al((size_t)MT * 256 * 2);
constexpr size_t WS_SEND = WS_AC + al((size_t)16 * 768 * 768 * 2);
constexpr size_t WS_MIXEND = WS_SEND + al((size_t)16 * 768 * 256 * 4);
constexpr size_t WS_END = WS_BIG + al((size_t)MT * 2816 * 2);
constexpr size_t WS_BAR = WS_END;
constexpr size_t WS_TOTAL = WS_BAR + 16384;
static_assert(WS_MIXEND <= WS_END, "mixer buffers must fit in the HID overlay");

constexpr int LDS_BYTES = 147456;

__device__ __forceinline__ unsigned cvt_pk_bf16(float lo, float hi) { unsigned r; asm volatile("v_cvt_pk_bf16_f32 %0, %1, %2" : "=v"(r) : "v"(lo), "v"(hi)); return r; }
__device__ __forceinline__ float bf2f(unsigned short b) { return __uint_as_float(((unsigned)b) << 16); }
__device__ __forceinline__ float bflo(unsigned w) { return __uint_as_float(w << 16); }
__device__ __forceinline__ float bfhi(unsigned w) { return __uint_as_float(w & 0xffff0000u); }
__device__ __forceinline__ float sigmoidf_(float x) { return __builtin_amdgcn_rcpf(1.0f + __builtin_amdgcn_exp2f(x * -1.4426950408889634f)); }
__device__ __forceinline__ float gelu_tanh(float x) { const float u = 1.5957691216f * (x + 0.044715f * x * x * x); return x * __builtin_amdgcn_rcpf(1.0f + __builtin_amdgcn_exp2f(u * -1.4426950408889634f)); }
__device__ __forceinline__ int cond_of_row(int m) { return m < MC ? 0 : 1 + ((m - MC) >> 11); }

namespace pg8 {
constexpr int BM = 256, BK = 64, HALF = 128, HTB = HALF * BK * 2, STAGE_BYTES = 8 * HTB, NXCD = 8, WGM = 4;
__host__ __device__ __forceinline__ int lds_byte(int r, int c) { const int st = (r >> 4) * 2 + (c >> 5), rr = r & 15, cc = c & 31, ob = rr * 64 + cc * 2; return st * 1024 + (ob ^ (((ob >> 9) & 1) << 5)); }
__host__ __device__ __forceinline__ void stage_rc(int b, int& R, int& C) { const int st = b / 1024, sb = b % 1024, swz = sb ^ (((sb >> 9) & 1) << 5); R = (st >> 1) * 16 + swz / 64; C = (st & 1) * 32 + (swz % 64) / 2; }
__host__ __device__ __forceinline__ int perm32(int rho) { const int n = rho >> 4, i = rho & 15; return 8 * (i >> 2) + 4 * n + (i & 3); }

struct Unit { const char* a; const char* b; int pm, pn, z; };

struct Sched {
    const char* A; const char* B; size_t aTile, bTile, aZ, bZ; int nM, nN, nwg, total, G, c, Lofs, pm0;
    __device__ __forceinline__ void init(const void* A_, const void* B_, int nM_, int nN_, int nZ_, size_t aTile_, size_t bTile_, size_t aZ_, size_t bZ_, int G_, int c_) {
        A = (const char*)A_; B = (const char*)B_; nM = nM_; nN = nN_; nwg = nM_ * nN_; total = nwg * nZ_; aTile = aTile_; bTile = bTile_; aZ = aZ_; bZ = bZ_; G = G_; c = c_; Lofs = 0; pm0 = 0; }
    __device__ __forceinline__ void range(int lo, int hi, int G_, int c_, int pm0_) { Lofs = lo; total = c_ < 0 ? lo : hi; G = G_; c = c_ < 0 ? 0 : c_; pm0 = pm0_; }
    __device__ __forceinline__ bool next(int i, Unit& u) const {
        const long L = (long)Lofs + (long)i * G + c; if (L >= total) return false;
        const int z = (int)(L / nwg); int wgid = (int)(L % nwg);
        { const int q = nwg / NXCD, r = nwg % NXCD, xcd = wgid % NXCD, off = wgid / NXCD; wgid = (xcd < r ? xcd * (q + 1) : r * (q + 1) + (xcd - r) * q) + off; }
        const int nig = WGM * nN, gid = wgid / nig, fm = gid * WGM, gsz = (nM - fm) < WGM ? (nM - fm) : WGM;
        u.pm = pm0 + fm + ((wgid % nig) % gsz); u.pn = (wgid % nig) / gsz; u.z = z;
        u.a = A + (size_t)z * aZ + (size_t)u.pm * aTile; u.b = B + (size_t)z * bZ + (size_t)u.pn * bTile; return true;
    }
};

template <class Epi>
__device__ __forceinline__ void gemm_phase(LAS unsigned char* lds, const int tid_in, const int ldA, const int ldB, const int K, const Sched& S, const Epi& E) {
    int tid_ = tid_in; asm volatile("" : "+v"(tid_));
    const int tid = tid_, wid = __builtin_amdgcn_readfirstlane(tid >> 6), lane = tid & 63, wr = wid >> 2, wc = wid & 3, fr = lane & 15, fq = lane >> 4;
    const int nt = K / BK;
    unsigned voffA[2], voffB[2];
#pragma unroll
    for (int i = 0; i < 2; ++i) { int R, C; stage_rc(tid * 16 + i * 8192, R, C); const int Rb = Epi::PERM ? ((R & ~31) + perm32(R & 31)) : R;
        voffA[i] = (unsigned)(R * ldA + C) * 2u; voffB[i] = (unsigned)(Rb * ldB + C) * 2u; }
    const size_t kstep = (size_t)(BK * 2);
    const size_t hstepA = (size_t)HALF * ldA * 2, hstepB = (size_t)HALF * ldB * 2;
    const unsigned ldsw = (unsigned)wid * 1024u;
    const int aoff = lds_byte(wr * 64 + fr, fq * 8), boff = lds_byte(wc * 32 + fr, fq * 8);
#define PG8_SA(b, h) (((b) * 2 + (h)) * HTB)
#define PG8_SB(b, h) ((4 + (b) * 2 + (h)) * HTB)
#define PG8_STAGE(bufoff, gbase, voff) do { _Pragma("unroll") for (int _i = 0; _i < 2; ++_i) \
        __builtin_amdgcn_global_load_lds((const unsigned*)((const char*)(gbase) + (voff)[_i]), (LAS unsigned*)(lds + (bufoff) + ldsw + _i * 8192), 16, 0, 0); } while (0)
#define PG8_LDA(dst, b, h) do { _Pragma("unroll") for (int m = 0; m < 4; ++m) _Pragma("unroll") for (int k = 0; k < 2; ++k) dst[m][k] = *(const LAS bf16x8*)(lds + PG8_SA(b, h) + aoff + m * 2048 + k * 1024); } while (0)
#define PG8_LDB(dst, b, h) do { _Pragma("unroll") for (int n = 0; n < 2; ++n) _Pragma("unroll") for (int k = 0; k < 2; ++k) dst[n][k] = *(const LAS bf16x8*)(lds + PG8_SB(b, h) + boff + n * 2048 + k * 1024); } while (0)
#define PG8_MMA(ai, bj, At, Bt) do { __builtin_amdgcn_s_setprio(1); _Pragma("unroll") for (int m = 0; m < 4; ++m) _Pragma("unroll") for (int n = 0; n < 2; ++n) _Pragma("unroll") for (int k = 0; k < 2; ++k) \
        acc[ai][bj][m][n] = __builtin_amdgcn_mfma_f32_16x16x32_bf16(Bt[n][k], At[m][k], acc[ai][bj][m][n], 0, 0, 0); __builtin_amdgcn_s_setprio(0); } while (0)
#define PG8_WAIT_V(n) asm volatile("s_waitcnt vmcnt(" #n ")" ::: "memory")
#define PG8_WAIT_L(n) asm volatile("s_waitcnt lgkmcnt(" #n ")" ::: "memory")
#define PG8_BAR __builtin_amdgcn_s_barrier()
#define PG8_SCHED __builtin_amdgcn_sched_barrier(0)
    Unit cur, nxt; int ui = 0;
    if (!S.next(0, cur)) return;
    f32x4 acc[2][2][4][2];
#pragma unroll
    for (int a = 0; a < 2; ++a)
#pragma unroll
        for (int b = 0; b < 2; ++b)
#pragma unroll
            for (int m = 0; m < 4; ++m)
#pragma unroll
                for (int n = 0; n < 2; ++n) acc[a][b][m][n] = (f32x4){0.f, 0.f, 0.f, 0.f};
    bf16x8 At[4][2], B0[2][2], B1[2][2];
    const char* cA = cur.a; const char* cB = cur.b;
    PG8_STAGE(PG8_SB(0, 0), cB, voffB); PG8_STAGE(PG8_SB(0, 1), cB + hstepB, voffB); PG8_STAGE(PG8_SA(0, 0), cA, voffA); PG8_STAGE(PG8_SA(0, 1), cA + hstepA, voffA);
    if (wr == 1) PG8_BAR;
    PG8_WAIT_V(2); PG8_BAR;
    PG8_STAGE(PG8_SB(1, 0), cB + kstep, voffB); PG8_STAGE(PG8_SA(1, 0), cA + kstep, voffA); PG8_STAGE(PG8_SB(1, 1), cB + hstepB + kstep, voffB);
    PG8_WAIT_V(6); PG8_BAR;
    for (;;) {
        const bool has_next = S.next(ui + 1, nxt);
        const char* nA = has_next ? nxt.a : cA; const char* nB = has_next ? nxt.b : cB;
        for (int t = 0; t < nt; t += 2) {
            const bool last = (t == nt - 2);
            const char* a1 = cA + (size_t)(t + 1) * kstep;
            const char* a2 = last ? nA : cA + (size_t)(t + 2) * kstep; const char* b2 = last ? nB : cB + (size_t)(t + 2) * kstep;
            const char* a3 = a2 + kstep; const char* b3 = b2 + kstep;
            PG8_LDB(B0, 0, 0); PG8_LDB(B1, 0, 1); PG8_SCHED; PG8_LDA(At, 0, 0); PG8_STAGE(PG8_SA(1, 1), a1 + hstepA, voffA);
            PG8_WAIT_V(8); PG8_WAIT_L(0); PG8_BAR; PG8_MMA(0, 0, At, B0); PG8_MMA(0, 1, At, B1); PG8_BAR; PG8_SCHED;
            PG8_LDA(At, 0, 1); PG8_STAGE(PG8_SB(0, 0), b2, voffB); PG8_STAGE(PG8_SB(0, 1), b2 + hstepB, voffB); PG8_STAGE(PG8_SA(0, 0), a2, voffA);
            PG8_WAIT_V(8); PG8_WAIT_L(0); PG8_BAR; PG8_MMA(1, 0, At, B0); PG8_MMA(1, 1, At, B1); PG8_BAR; PG8_SCHED;
            PG8_LDB(B0, 1, 0); PG8_LDB(B1, 1, 1); PG8_SCHED; PG8_LDA(At, 1, 0); PG8_STAGE(PG8_SA(0, 1), a2 + hstepA, voffA);
            PG8_WAIT_V(8); PG8_WAIT_L(0); PG8_BAR; PG8_MMA(0, 0, At, B0); PG8_MMA(0, 1, At, B1); PG8_BAR; PG8_SCHED;
            PG8_LDA(At, 1, 1); PG8_STAGE(PG8_SB(1, 0), b3, voffB); PG8_STAGE(PG8_SB(1, 1), b3 + hstepB, voffB); PG8_STAGE(PG8_SA(1, 0), a3, voffA);
            PG8_WAIT_V(8); PG8_WAIT_L(0); PG8_BAR; PG8_MMA(1, 0, At, B0); PG8_MMA(1, 1, At, B1); PG8_BAR; PG8_SCHED;
        }
        if (wr == 0) PG8_BAR;
        E(acc, cur, wr, wc, fr, fq);
        if (!has_next) break;
#pragma unroll
        for (int a = 0; a < 2; ++a)
#pragma unroll
            for (int b = 0; b < 2; ++b)
#pragma unroll
                for (int m = 0; m < 4; ++m)
#pragma unroll
                    for (int n = 0; n < 2; ++n) acc[a][b][m][n] = (f32x4){0.f, 0.f, 0.f, 0.f};
        cur = nxt; cA = nA; cB = nB; ++ui;
        if (wr == 1) PG8_BAR;
    }
    PG8_WAIT_V(0);
    PG8_BAR;
#undef PG8_SA
#undef PG8_SB
#undef PG8_STAGE
#undef PG8_LDA
#undef PG8_LDB
#undef PG8_MMA
#undef PG8_WAIT_V
#undef PG8_WAIT_L
#undef PG8_BAR
#undef PG8_SCHED
}

typedef const f32x4 (&AccRef)[2][2][4][2];
template <int ACT  > struct EpiGated {
    static constexpr bool PERM = true;
    bf16_t* O; int ldc;
    __device__ __forceinline__ void operator()(AccRef acc, const Unit& u, int wr, int wc, int fr, int fq) const {
        const int row0 = u.pm * BM + wr * 64 + fr, hcol0 = u.pn * 128 + wc * 16 + 4 * fq;
#pragma unroll
        for (int ai = 0; ai < 2; ++ai)
#pragma unroll
            for (int m = 0; m < 4; ++m) { int rr_ = row0 + ai * HALF + m * 16; asm volatile("" : "+v"(rr_) :: "memory"); bf16_t* rowp = O + (size_t)rr_ * ldc + hcol0;
#pragma unroll
                for (int bj = 0; bj < 2; ++bj) { const f32x4 a = acc[ai][bj][m][0], b = acc[ai][bj][m][1]; float v[4];
#pragma unroll
                    for (int j = 0; j < 4; ++j) v[j] = (ACT == 0) ? a[j] * sigmoidf_(a[j]) * b[j] : a[j] * sigmoidf_(b[j]);
                    u32x2 w; w.x = cvt_pk_bf16(v[0], v[1]); w.y = cvt_pk_bf16(v[2], v[3]); *(u32x2*)(rowp + bj * 64) = w; } }
    }
};
template <int NB, int HALFC> struct EpiResidT {
    static constexpr bool PERM = false; static constexpr float coef = HALFC ? 0.5f : 1.0f;
    float* X; const float* gate; const float* Xs;
    __device__ __forceinline__ void operator()(AccRef acc, const Unit& u, int wr, int wc, int fr, int fq) const {
        const int cond = (u.pm < 32) ? 0 : 1 + ((u.pm - 32) >> 3);
        const float* gp = gate + (size_t)cond * 9216;
        const int col0 = u.pn * BM + wc * 32 + 4 * fq;
        f32x4 gv[2][2];
#pragma unroll
        for (int bj = 0; bj < 2; ++bj)
#pragma unroll
            for (int n = 0; n < 2; ++n) gv[bj][n] = *(const f32x4*)(gp + col0 + bj * HALF + n * 16) * coef;
        constexpr int RPB = 8 / NB;
#pragma unroll
        for (int b = 0; b < NB; ++b) {
            int r0 = u.pm * BM + wr * 64 + fr; asm volatile("" : "+v"(r0) :: "memory");
            f32x4 xv[RPB][2][2];
#pragma unroll
            for (int q = 0; q < RPB; ++q) { const int am = b * RPB + q, ai = am >> 2, m = am & 3; const float* rowp = Xs + (size_t)(r0 + ai * HALF + m * 16) * DM + col0;
#pragma unroll
                for (int bj = 0; bj < 2; ++bj)
#pragma unroll
                    for (int n = 0; n < 2; ++n) xv[q][bj][n] = *(const f32x4*)(rowp + bj * HALF + n * 16); }
#pragma unroll
            for (int q = 0; q < RPB; ++q) { const int am = b * RPB + q, ai = am >> 2, m = am & 3; float* rowp = X + (size_t)(r0 + ai * HALF + m * 16) * DM + col0;
#pragma unroll
                for (int bj = 0; bj < 2; ++bj)
#pragma unroll
                    for (int n = 0; n < 2; ++n) *(f32x4*)(rowp + bj * HALF + n * 16) = xv[q][bj][n] + gv[bj][n] * acc[ai][bj][m][n]; }
        }
    }
};
__device__ __forceinline__ u32x4 pack8(const f32x4 v0, const f32x4 v1) { u32x4 w; w.x = cvt_pk_bf16(v0[0], v0[1]); w.y = cvt_pk_bf16(v0[2], v0[3]); w.z = cvt_pk_bf16(v1[0], v1[1]); w.w = cvt_pk_bf16(v1[2], v1[3]); return w; }
struct EpiWin {
    static constexpr bool PERM = true;
    bf16_t *MIX, *KVRAW, *UT, *AC;
    __device__ __forceinline__ void operator()(AccRef acc, const Unit& u, int wr, int wc, int fr, int fq) const {
#pragma unroll
        for (int ai = 0; ai < 2; ++ai)
#pragma unroll
            for (int m = 0; m < 4; ++m) { int row = u.pm * BM + ai * HALF + wr * 64 + m * 16 + fr; asm volatile("" : "+v"(row) :: "memory");
#pragma unroll
                for (int bj = 0; bj < 2; ++bj) { const int c0 = u.pn * BM + bj * HALF + wc * 32 + 8 * fq; const f32x4 v0 = acc[ai][bj][m][0], v1 = acc[ai][bj][m][1];
                    if (u.pn <= 1) { *(u32x4*)(MIX + (size_t)row * MIXW + c0) = pack8(v0, v1); }
                    else if (u.pn == 2) { *(u32x4*)(KVRAW + (size_t)row * 256 + (c0 - 512)) = pack8(v0, v1); }
                    else if (u.pn == 3) { const int ch0 = c0 - 768; bf16_t* p;
                        if (row < MC) p = UT + ((size_t)((row >> 8) * 256 + ch0)) * 256 + (row & 255);
                        else { const int rr = row - MC, t = rr & 2047; p = UT + (size_t)MC * 256 + ((size_t)((((rr >> 11) * 2 + (ch0 >> 7)) * 2 + (t & 1)) * 128 + (ch0 & 127))) * 1024 + (t >> 1); }
                        const size_t st = (row < MC) ? 256 : 1024; const u32x4 w = pack8(v0, v1);
                        p[0] = (bf16_t)(w.x & 0xffff); p[st] = (bf16_t)(w.x >> 16); p[2 * st] = (bf16_t)(w.y & 0xffff); p[3 * st] = (bf16_t)(w.y >> 16);
                        p[4 * st] = (bf16_t)(w.z & 0xffff); p[5 * st] = (bf16_t)(w.z >> 16); p[6 * st] = (bf16_t)(w.w & 0xffff); p[7 * st] = (bf16_t)(w.w >> 16); }
                    else { const int cc = c0 - 1024, g = cc >> 4, h0 = cc & 15, chunk = row >> 5, tp = row & 31;
                        *(u32x4*)(AC + ((size_t)g * 768 + chunk) * 768 + tp * 16 + h0) = pack8(v0, v1); } } }
    }
};
template <int LAT> struct EpiDFT {
    static constexpr bool PERM = true;
    bf16_t* MIX;
    __device__ __forceinline__ void operator()(AccRef acc, const Unit& u, int wr, int wc, int fr, int fq) const {
#pragma unroll
        for (int ai = 0; ai < 2; ++ai)
#pragma unroll
            for (int m = 0; m < 4; ++m) { int R = u.pm * BM + ai * HALF + wr * 64 + m * 16 + fr; asm volatile("" : "+v"(R) :: "memory");
                const int cs = LAT ? (R >> 11) : (R >> 8), k = LAT ? (R & 2047) : (R & 255), tok = LAT ? (MC + u.z * 2048 + k) : (u.z * 256 + k);
#pragma unroll
                for (int bj = 0; bj < 2; ++bj) { const int ch0 = bj * HALF + wc * 32 + 8 * fq;
                    *(u32x4*)(MIX + (size_t)tok * MIXW + 512 + cs * 256 + ch0) = pack8(acc[ai][bj][m][0], acc[ai][bj][m][1]); } }
    }
};
struct EpiFold {
    static constexpr bool PERM = false;
    bf16_t* WO;
    __device__ __forceinline__ void operator()(AccRef acc, const Unit& u, int wr, int wc, int fr, int fq) const {
#pragma unroll
        for (int ai = 0; ai < 2; ++ai)
#pragma unroll
            for (int m = 0; m < 4; ++m) { int R = u.pm * BM + ai * HALF + wr * 64 + m * 16 + fr; asm volatile("" : "+v"(R) :: "memory");
#pragma unroll
                for (int bj = 0; bj < 2; ++bj)
#pragma unroll
                    for (int n = 0; n < 2; ++n) { const int c = u.pn * BM + bj * HALF + wc * 32 + n * 16 + 4 * fq; const f32x4 v = acc[ai][bj][m][n];
                        bf16_t* p = WO + ((size_t)u.z * 1024 + c) * 1280 + 512 + R; const unsigned w0 = cvt_pk_bf16(v[0], v[1]), w1 = cvt_pk_bf16(v[2], v[3]);
                        p[0] = (bf16_t)(w0 & 0xffff); p[1280] = (bf16_t)(w0 >> 16); p[2560] = (bf16_t)(w1 & 0xffff); p[3840] = (bf16_t)(w1 >> 16); } }
    }
};
struct EpiDFT2 {
    static constexpr bool PERM = true;
    bf16_t* MIX; const f32x2* TW;
    __device__ __forceinline__ void operator()(AccRef acc, const Unit& u, int wr, int wc, int fr, int fq) const {
        const int ch0 = u.pn * 128 + wc * 32 + 8 * fq;
#pragma unroll
        for (int m = 0; m < 4; ++m) { int kp = u.pm * 128 + wr * 64 + m * 16 + fr; asm volatile("" : "+v"(kp) :: "memory");
            const f32x2 tw = TW[kp]; const float c = tw.x, s = tw.y;
            bf16_t* p1 = MIX + (size_t)(MC + u.z * 2048 + kp) * MIXW + 512 + ch0; bf16_t* p2 = p1 + (size_t)1024 * MIXW;
            f32x4 C1[2], S1[2], C2[2], S2[2];
#pragma unroll
            for (int n = 0; n < 2; ++n) { const f32x4 Ec = acc[0][0][m][n], Es = acc[1][0][m][n], Oc = acc[0][1][m][n], Os = acc[1][1][m][n];
                const f32x4 tc = Oc * c - Os * s, ts = Os * c + Oc * s; C1[n] = Ec + tc; S1[n] = Es + ts; C2[n] = Ec - tc; S2[n] = Es - ts; }
            *(u32x4*)p1 = pack8(C1[0], C1[1]); *(u32x4*)(p1 + 256) = pack8(S1[0], S1[1]); *(u32x4*)p2 = pack8(C2[0], C2[1]); *(u32x4*)(p2 + 256) = pack8(S2[0], S2[1]); }
    }
};
struct EpiSsmA {
    static constexpr bool PERM = false;
    float* SEND;
    __device__ __forceinline__ void operator()(AccRef acc, const Unit& u, int wr, int wc, int fr, int fq) const {
#pragma unroll
        for (int ai = 0; ai < 2; ++ai)
#pragma unroll
            for (int m = 0; m < 4; ++m) { int R = u.pm * BM + ai * HALF + wr * 64 + m * 16 + fr; asm volatile("" : "+v"(R) :: "memory"); float* rowp = SEND + ((size_t)u.z * 768 + R) * 256 + wc * 32 + 4 * fq;
#pragma unroll
                for (int bj = 0; bj < 2; ++bj)
#pragma unroll
                    for (int n = 0; n < 2; ++n) *(f32x4*)(rowp + bj * HALF + n * 16) = acc[ai][bj][m][n]; }
    }
};
struct EpiSsmC {
    static constexpr bool PERM = true;
    bf16_t* Y;
    __device__ __forceinline__ void operator()(AccRef acc, const Unit& u, int wr, int wc, int fr, int fq) const {
#pragma unroll
        for (int ai = 0; ai < 2; ++ai)
#pragma unroll
            for (int m = 0; m < 4; ++m) { int R = u.pm * BM + ai * HALF + wr * 64 + m * 16 + fr; asm volatile("" : "+v"(R) :: "memory");
#pragma unroll
                for (int bj = 0; bj < 2; ++bj) { const int c0 = u.pn * BM + bj * HALF + wc * 32 + 8 * fq, tp = c0 >> 4, h0 = c0 & 15;
                    f32x4 v0 = acc[ai][bj][m][0], v1 = acc[ai][bj][m][1];
#pragma unroll
                    for (int j = 0; j < 4; ++j) { v0[j] = gelu_tanh(v0[j]); v1[j] = gelu_tanh(v1[j]); }
                    *(u32x4*)(Y + (size_t)(R * 32 + tp) * 256 + u.z * 16 + h0) = pack8(v0, v1); } }
    }
};
}

using pg8::pack8;
struct Args { const float* in[N_IN]; float* out; unsigned char* ws; };
constexpr int PTR_OFF = 146944;
struct Ctx {
    float* out; unsigned char* ws;
    LAS unsigned char* lds;
    int wid0; int tid, lane, wid, G, bx, gw, NGW, gtid, NGT;
};
__device__ __forceinline__ const float* inp(const Ctx& C, int i) { return *(const float* const LAS*)(C.lds + PTR_OFF + i * 8); }
__device__ __forceinline__ unsigned char* opq(unsigned char* p) { asm volatile("" : "+s"(p)); return p; }
__device__ __forceinline__ float* opq(float* p) { asm volatile("" : "+s"(p)); return p; }
__device__ __forceinline__ void refresh(Ctx& C) {
    int w0 = C.wid0; asm volatile("" : "+s"(w0)); int ln; asm volatile("v_mbcnt_lo_u32_b32 %0, -1, 0\n\tv_mbcnt_hi_u32_b32 %0, -1, %0" : "=&v"(ln));
    int t = w0 * 64 + ln; int b = blockIdx.x; asm volatile("" : "+s"(b)); int g = gridDim.x; asm volatile("" : "+s"(g));
    C.tid = t; C.lane = ln; C.wid = w0; C.G = g; C.bx = b;
    C.gw = b * 8 + C.wid; C.NGW = g * 8; C.gtid = b * 512 + t; C.NGT = g * 512;
    C.ws = opq(C.ws); C.out = opq(C.out);
}
__device__ __forceinline__ float shx(float v, int k, int lane) { return __int_as_float(__builtin_amdgcn_ds_bpermute((lane ^ k) << 2, __float_as_int(v))); }
__device__ __forceinline__ float wave_sum(float v, int lane) {
#pragma unroll
    for (int o = 1; o < 64; o <<= 1) v += shx(v, o, lane);
    return v;
}

__device__ __forceinline__ void p0_mod(Ctx C) {
    refresh(C);
    LAS float* s = (LAS float*)C.lds;
    LAS float* red = (LAS float*)(C.lds + 9 * 1024 * 4);
    float* mod = (float*)(C.ws + WS_MOD);
    for (int i = C.tid; i < 9 * 1024; i += 512) { const int c = i >> 10, k = i & 1023; const float v = (c == 0) ? inp(C, I_CCTX)[k] : inp(C, I_C)[(c - 1) * 1024 + k]; s[i] = v * sigmoidf_(v); }
    __syncthreads();
    for (int it = C.bx; it < 576; it += C.G) {
        const int l = it / 288, n0 = (it % 288) * 32;
        const float* W = inp(C, I_WMOD) + (size_t)l * 1024 * 9216 + n0 + (C.lane & 31);
        float acc[9];
#pragma unroll
        for (int c = 0; c < 9; ++c) acc[c] = 0.f;
        const int k0 = C.wid * 128 + (C.lane >> 5);
#pragma unroll 16
        for (int kk = 0; kk < 64; ++kk) { const int k = k0 + 2 * kk; const float w = __builtin_nontemporal_load(W + (size_t)k * 9216);
#pragma unroll
            for (int c = 0; c < 9; ++c) acc[c] += s[c * 1024 + k] * w; }
#pragma unroll
        for (int c = 0; c < 9; ++c) red[(C.wid * 9 + c) * 64 + C.lane] = acc[c];
        __syncthreads();
        for (int i = C.tid; i < 9 * 32; i += 512) { const int c = i >> 5, n = i & 31; float v = 0.f;
#pragma unroll
            for (int w = 0; w < 8; ++w) v += red[(w * 9 + c) * 64 + n] + red[(w * 9 + c) * 64 + 32 + n];
            mod[((size_t)l * 9 + c) * 9216 + n0 + n] = v + inp(C, I_BMOD)[(size_t)l * 9216 + n0 + n]; }
        __syncthreads();
    }
}

struct TDesc { const float* src; bf16_t* dst; int N, ldt, n0, mode, which, nsub; };
__device__ __forceinline__ void t_make(TDesc& d, const float* W, int N, int ksrc0, bf16_t* WT, int ldt, int koff, int mode, int which, int nsub, int item, int nblk) {
    const int kb = item / nblk, nb = item % nblk, k0 = 64 * kb, n0 = 32 * nb;
    d.src = W + (size_t)(ksrc0 + k0) * N + n0; d.dst = WT + koff + k0; d.N = N; d.ldt = ldt; d.n0 = n0; d.mode = mode; d.which = which; d.nsub = nsub;
}
__device__ __forceinline__ void t_decode(const Ctx& C, int it, TDesc& d) {
    constexpr int PER_L = 8448 + 640 + 256 + 128 + 128 + 64;
    const int l = it / PER_L; int r = it % PER_L;
    if (r < 8448) { const int f = r / 4224, rr = r % 4224, which = rr / 1408, idx = rr % 1408; const size_t lf = (size_t)(l * 2 + f);
        if (which < 2) t_make(d, (which == 0 ? inp(C, I_W1) : inp(C, I_W3)) + lf * 1024 * 2816, 2816, 0, (bf16_t*)(C.ws + WS_W13T) + lf * 5632 * 1024, 1024, 0, 1, which, 0, idx, 88);
        else t_make(d, inp(C, I_W2) + lf * 2816 * 1024, 1024, 0, (bf16_t*)(C.ws + WS_W2T) + lf * 1024 * 2816, 2816, 0, 0, 0, 0, idx, 32);
        return; }
    r -= 8448;
    if (r < 640) { t_make(d, inp(C, I_WIN) + (size_t)l * 1024 * 1280, 1280, 0, (bf16_t*)(C.ws + WS_WINT) + (size_t)l * 1280 * 1024, 1024, 0, 0, 0, 0, r, 40); return; }
    r -= 640;
    if (r < 256) { t_make(d, inp(C, I_WOUT) + (size_t)l * 1024 * 1024, 1024, 0, (bf16_t*)(C.ws + WS_WOUTT) + (size_t)l * 1024 * 1280, 1280, 0, 0, 0, 0, r, 32); return; }
    r -= 256;
    if (r < 128) { t_make(d, inp(C, I_WOUT) + (size_t)l * 1024 * 1024, 1024, 768, (bf16_t*)(C.ws + WS_WOUTT) + (size_t)l * 1024 * 1280, 1280, 1024, 0, 0, 0, r, 32); return; }
    r -= 128;
    if (r < 128) { t_make(d, inp(C, I_WOUT) + (size_t)l * 1024 * 1024, 1024, 512, (bf16_t*)(C.ws + WS_WOFT) + (size_t)l * 1024 * 256, 256, 0, 0, 0, 0, r, 32); return; }
    r -= 128;
    { const int nb = r % 16; const int which = nb >> 3;
      t_make(d, inp(C, I_GLU) + (size_t)l * 256 * 512, 512, 0, (bf16_t*)(C.ws + WS_WGLUT) + (size_t)l * 512 * 256, 256, 0, 1, which, which * 256, r, 16); }
}
__device__ __forceinline__ void t_load(const TDesc& d, float (&v)[32], int lane) {
#pragma unroll
    for (int i = 0; i < 32; ++i) v[i] = __builtin_nontemporal_load(d.src + (size_t)(2 * i + (lane >> 5)) * d.N + (lane & 31));
}
__device__ __forceinline__ void t_finish(const TDesc& d, const float (&v)[32], LAS float* scr, int lane) {
#pragma unroll
    for (int i = 0; i < 32; ++i) scr[(2 * i + (lane >> 5)) * 33 + (lane & 31)] = v[i];
    asm volatile("s_waitcnt lgkmcnt(0)" ::: "memory");
    const int c = lane & 7;
#pragma unroll
    for (int j = 0; j < 4; ++j) { const int n = (lane >> 3) + 8 * j; const LAS float* sp = scr + (8 * c) * 33 + n;
        u32x4 o; o.x = cvt_pk_bf16(sp[0 * 33], sp[1 * 33]); o.y = cvt_pk_bf16(sp[2 * 33], sp[3 * 33]); o.z = cvt_pk_bf16(sp[4 * 33], sp[5 * 33]); o.w = cvt_pk_bf16(sp[6 * 33], sp[7 * 33]);
        int row = d.n0 + n; if (d.mode == 1) { const int h = row - d.nsub; row = (h >> 2) * 8 + d.which * 4 + (h & 3); }
        *(u32x4*)(d.dst + (size_t)row * d.ldt + 8 * c) = o; }
    asm volatile("s_waitcnt lgkmcnt(0)" ::: "memory");
}
__device__ __forceinline__ void p0_weights(Ctx C, int l_lo, int l_hi, int wg_lo) {
    refresh(C);
    if (C.bx < wg_lo) return;
    C.gw -= wg_lo * 8; C.NGW -= wg_lo * 8;
    LAS float* scr = (LAS float*)(C.lds + 65536 + C.wid * 8448);
    constexpr int PER_L = 8448 + 640 + 256 + 128 + 128 + 64;
    const int end = l_hi * PER_L;
    int it = l_lo * PER_L + C.gw;
    if (it >= end) return;
    TDesc da; float va[32];
    t_decode(C, it, da); t_load(da, va, C.lane);
    for (;;) {
        const int nx = it + C.NGW; const bool hn = nx < end;
        TDesc db = da; float vb[32];
        if (hn) { t_decode(C, nx, db); t_load(db, vb, C.lane); }
        t_finish(da, va, scr, C.lane);
        if (!hn) break;
        da = db; it = nx;
#pragma unroll
        for (int i = 0; i < 32; ++i) va[i] = vb[i];
    }
}

__device__ __forceinline__ void p0_tables(Ctx C) {
    refresh(C);
    { f32x2* P = (f32x2*)(C.ws + WS_PTAB);
      for (int i = C.gtid; i < 2 * 2 * 16 * 64 * 34; i += C.NGT) { const int e = i % 34, ch = i / 34;
        const double lre = (double)inp(C, I_LRE)[ch], lim = (double)inp(C, I_LIM)[ch], step = exp((double)inp(C, I_LS)[ch >> 6]);
        const double ee = (e <= 32) ? (double)e : 1.0;
        const double mag = exp(lre * step * ee); double ang = lim * step * ee; ang -= 6.283185307179586476925 * rint(ang / 6.283185307179586476925);
        double pr = mag * cos(ang), pi = mag * sin(ang);
        if (e == 33) { const double nr = pr - 1.0, ni = pi, den = lre * lre + lim * lim; pr = (nr * lre + ni * lim) / den; pi = (ni * lre - nr * lim) / den; }
        P[i] = (f32x2){(float)pr, (float)pi}; } }
    { bf16_t* D = (bf16_t*)(C.ws + WS_DFTL); const float sc = 0.00276213586f;
      for (int i = C.gtid; i < 2048 * 128; i += C.NGT) { const int row = i >> 7, t0 = (i & 127) * 8, cs = (row >> 7) & 1, k = (row >> 8) * 128 + (row & 127); float v[8];
#pragma unroll
        for (int j = 0; j < 8; ++j) { const int ph = (k * (t0 + j)) & 1023; const float x = (float)ph * (1.0f / 512.0f); v[j] = (cs ? sinpif(x) : cospif(x)) * sc; }
        u32x4 w; w.x = cvt_pk_bf16(v[0], v[1]); w.y = cvt_pk_bf16(v[2], v[3]); w.z = cvt_pk_bf16(v[4], v[5]); w.w = cvt_pk_bf16(v[6], v[7]);
        *(u32x4*)(D + (size_t)row * 1024 + t0) = w; }
      f32x2* T = (f32x2*)(C.ws + WS_TWID);
      for (int i = C.gtid; i < 1024; i += C.NGT) { const float x = (float)i * (1.0f / 1024.0f); T[i] = (f32x2){cospif(x), sinpif(x)}; } }
    { bf16_t* D = (bf16_t*)(C.ws + WS_DFTC); const float sc = 0.0078125f;
      for (int i = C.gtid; i < 512 * 32; i += C.NGT) { const int row = i >> 5, t0 = (i & 31) * 8, cs = row >> 8, k = row & 255; float v[8];
#pragma unroll
        for (int j = 0; j < 8; ++j) { const int ph = (k * (t0 + j)) & 255; const float x = (float)ph * (1.0f / 128.0f); v[j] = (cs ? sinpif(x) : cospif(x)) * sc; }
        u32x4 w; w.x = cvt_pk_bf16(v[0], v[1]); w.y = cvt_pk_bf16(v[2], v[3]); w.z = cvt_pk_bf16(v[4], v[5]); w.w = cvt_pk_bf16(v[6], v[7]);
        *(u32x4*)(D + (size_t)row * 256 + t0) = w; } }
    { LAS float* ctab = (LAS float*)(C.lds + 140000);
      if (C.tid < 64) ctab[C.tid] = cospif((float)C.tid * (1.0f / 32.0f));
      __syncthreads();
      bf16_t* TW = (bf16_t*)(C.ws + WS_TW);
      for (int i = C.gtid; i < 2 * 512 * 256; i += C.NGT) { const int j = i & 255, kk = (i >> 8) & 511, l = i >> 17, cs = kk >> 8, hd = (kk >> 6) & 3, d = kk & 63;
        const float* wf = inp(C, I_WF) + ((size_t)l * 256 + hd * 64) * 256 + j; float a = 0.f;
#pragma unroll 16
        for (int m = 0; m < 64; ++m) { const int ph = (d * m) & 63; const float t = cs ? -ctab[(ph + 48) & 63] : ctab[ph]; a += t * wf[(size_t)m * 256]; }
        TW[i] = (bf16_t)(cvt_pk_bf16(a, a) & 0xffff); } }
    { f32x2* R = (f32x2*)(C.ws + WS_ROPE);
      for (int i = C.gtid; i < 1024; i += C.NGT) { const int pos = i >> 4, fi = i & 15; const float invf = exp2f(-(float)fi * (13.287712379549449f / 16.0f)); const float ang = (float)pos * invf;
        R[i] = (f32x2){(float)cos((double)ang), (float)sin((double)ang)}; } }
    { bf16_t* Kc = (bf16_t*)(C.ws + WS_KC);
      for (int i = C.gtid; i < 2 * 8 * 256 * 16; i += C.NGT) { const int c8 = i & 15, t = (i >> 4) & 255, b = (i >> 12) & 7, l = i >> 15;
        const float* src = inp(C, I_CK) + (((size_t)(b * 2 + l) * 256 + t) * 128 + c8 * 8); const f32x4 a = *(const f32x4*)src, bb = *(const f32x4*)(src + 4);
        u32x4 w; w.x = cvt_pk_bf16(a[0], a[1]); w.y = cvt_pk_bf16(a[2], a[3]); w.z = cvt_pk_bf16(bb[0], bb[1]); w.w = cvt_pk_bf16(bb[2], bb[3]);
        *(u32x4*)(Kc + (((size_t)(l * 8 + b) * 256 + t) * 128 + c8 * 8)) = w; }
      bf16_t* Vt = (bf16_t*)(C.ws + WS_VTC);
      for (int i = C.gtid; i < 2 * 8 * 128 * 32; i += C.NGT) { const int t8 = i & 31, hd = (i >> 5) & 127, b = (i >> 12) & 7, l = i >> 15;
        const float* src = inp(C, I_CV) + (((size_t)(b * 2 + l) * 256 + t8 * 8) * 128 + hd); float v[8];
#pragma unroll
        for (int j = 0; j < 8; ++j) v[j] = src[(size_t)j * 128];
        u32x4 w; w.x = cvt_pk_bf16(v[0], v[1]); w.y = cvt_pk_bf16(v[2], v[3]); w.z = cvt_pk_bf16(v[4], v[5]); w.w = cvt_pk_bf16(v[6], v[7]);
        *(u32x4*)(Vt + (((size_t)(l * 8 + b) * 128 + hd) * 256 + t8 * 8)) = w; } }
}

__device__ __forceinline__ void p1_tables(Ctx C, int wg_lo) {
    refresh(C);
    if (C.bx < wg_lo) return;
    C.bx -= wg_lo; C.G -= wg_lo; C.gtid -= wg_lo * 512; C.NGT -= wg_lo * 512;
    const f32x2* P = (const f32x2*)(C.ws + WS_PTAB);
    { float* Kt = (float*)(C.ws + WS_KTAB);
      LAS f32x2* sCt = (LAS f32x2*)C.lds;
      LAS f32x2* sW = sCt + 1024;
      LAS float* sBr = (LAS float*)(sW + 2048);
      LAS float* sBi = sBr + 1024;
      for (int task = C.bx; task < 64; task += C.G) { const int r = task & 1, g = (task >> 1) & 15, l = task >> 5; const int chb = (l * 2 + r) * 16 + g;
        for (int i = C.tid; i < 1024; i += 512) { const int p = i >> 4, h = i & 15; sCt[i] = (f32x2){inp(C, I_CRE)[((size_t)chb * 16 + h) * 64 + p], inp(C, I_CIM)[((size_t)chb * 16 + h) * 64 + p]};
            sBr[i] = inp(C, I_BRE)[(size_t)chb * 1024 + i]; sBi[i] = inp(C, I_BIM)[(size_t)chb * 1024 + i]; }
        for (int i = C.tid; i < 2048; i += 512) { const int p = i >> 5, tau = i & 31; const f32x2 pw = P[((size_t)chb * 64 + p) * 34 + tau], cf = P[((size_t)chb * 64 + p) * 34 + 33];
            sW[i] = (f32x2){pw.x * cf.x - pw.y * cf.y, pw.x * cf.y + pw.y * cf.x}; }
        __syncthreads();
        const int tau = C.tid >> 4, h = C.tid & 15; float acc[16];
#pragma unroll
        for (int q = 0; q < 16; ++q) acc[q] = 0.f;
        for (int p = 0; p < 64; ++p) { const f32x2 ct = sCt[p * 16 + h], w = sW[p * 32 + tau]; const float zr = ct.x * w.x - ct.y * w.y, zi = ct.x * w.y + ct.y * w.x;
#pragma unroll
            for (int q4 = 0; q4 < 4; ++q4) { const f32x4 br = *(const LAS f32x4*)(sBr + p * 16 + q4 * 4), bi = *(const LAS f32x4*)(sBi + p * 16 + q4 * 4);
#pragma unroll
                for (int q = 0; q < 4; ++q) acc[q4 * 4 + q] += zr * br[q] - zi * bi[q]; } }
        float* dst = Kt + ((((size_t)(l * 16 + g) * 2 + r) * 32 + tau) * 16 + h) * 16;
#pragma unroll
        for (int q4 = 0; q4 < 4; ++q4) *(f32x4*)(dst + q4 * 4) = (f32x4){acc[q4 * 4], acc[q4 * 4 + 1], acc[q4 * 4 + 2], acc[q4 * 4 + 3]};
        __syncthreads(); } }
    { bf16_t* WA = (bf16_t*)(C.ws + WS_WAT);
      for (int i = C.gtid; i < 2 * 16 * 256 * 64; i += C.NGT) { const int k8 = i & 63, n = (i >> 6) & 255, g = (i >> 14) & 15, l = i >> 18;
        const int r = n >> 7, ri = (n >> 6) & 1, p = n & 63, j = k8 >> 1, h0 = (k8 & 1) * 8, e = r == 0 ? 31 - j : j;
        const int ch = ((l * 2 + r) * 16 + g) * 64 + p; const f32x2 pw = P[(size_t)ch * 34 + e], cf = P[(size_t)ch * 34 + 33];
        const float wr_ = pw.x * cf.x - pw.y * cf.y, wi_ = pw.x * cf.y + pw.y * cf.x; float v[8];
#pragma unroll
        for (int q = 0; q < 8; ++q) { const float br = inp(C, I_BRE)[(size_t)ch * 16 + h0 + q], bi = inp(C, I_BIM)[(size_t)ch * 16 + h0 + q]; v[q] = ri == 0 ? (wr_ * br - wi_ * bi) : (wr_ * bi + wi_ * br); }
        u32x4 w; w.x = cvt_pk_bf16(v[0], v[1]); w.y = cvt_pk_bf16(v[2], v[3]); w.z = cvt_pk_bf16(v[4], v[5]); w.w = cvt_pk_bf16(v[6], v[7]);
        *(u32x4*)(WA + (((size_t)(l * 16 + g) * 256 + n) * 512 + k8 * 8)) = w; } }
}
__device__ __forceinline__ void p2_tables(Ctx C, int wg_lo) {
    refresh(C);
    if (C.bx < wg_lo) return;
    C.gtid -= wg_lo * 512; C.NGT -= wg_lo * 512;
    const f32x2* P = (const f32x2*)(C.ws + WS_PTAB); const float* Kt = (const float*)(C.ws + WS_KTAB); bf16_t* Mt = (bf16_t*)(C.ws + WS_MTT);
    for (int i = C.gtid; i < 2 * 16 * 512 * 96; i += C.NGT) { const int k8 = i % 96, rest = i / 96, n = rest & 511, g = (rest >> 9) & 15, l = rest >> 13;
        const int tp = n >> 4, h = n & 15; float v[8];
        if (k8 < 64) { const int j = k8 >> 1, hp0 = (k8 & 1) * 8;
#pragma unroll
            for (int q = 0; q < 8; ++q) v[q] = 0.f;
            if (j <= tp) { const float* kf = Kt + ((((size_t)(l * 16 + g) * 2 + 0) * 32 + (tp - j)) * 16 + h) * 16 + hp0;
#pragma unroll
                for (int q = 0; q < 8; ++q) v[q] += kf[q]; }
            if (j >= tp) { const float* kb = Kt + ((((size_t)(l * 16 + g) * 2 + 1) * 32 + (j - tp)) * 16 + h) * 16 + hp0;
#pragma unroll
                for (int q = 0; q < 8; ++q) v[q] += kb[q]; }
            if (j == tp && h >= hp0 && h < hp0 + 8) { const float dv = inp(C, I_SD)[(size_t)(l * 16 + g) * 16 + h];
#pragma unroll
                for (int q = 0; q < 8; ++q) if (hp0 + q == h) v[q] += dv; }
        } else { const int kk = (k8 - 64) * 8, r = kk >> 7, ri = (kk >> 6) & 1, p0 = kk & 63, e = r == 0 ? tp + 1 : 32 - tp;
            const int chb = ((l * 2 + r) * 16 + g);
#pragma unroll
            for (int q = 0; q < 8; ++q) { const int p = p0 + q; const f32x2 pw = P[((size_t)chb * 64 + p) * 34 + e];
                const float cr = inp(C, I_CRE)[((size_t)chb * 16 + h) * 64 + p], ci = inp(C, I_CIM)[((size_t)chb * 16 + h) * 64 + p];
                v[q] = ri == 0 ? (cr * pw.x - ci * pw.y) : -(cr * pw.y + ci * pw.x); } }
        u32x4 w; w.x = cvt_pk_bf16(v[0], v[1]); w.y = cvt_pk_bf16(v[2], v[3]); w.z = cvt_pk_bf16(v[4], v[5]); w.w = cvt_pk_bf16(v[6], v[7]);
        *(u32x4*)(Mt + (((size_t)(l * 16 + g) * 512 + n) * 768 + k8 * 8)) = w; }
}

__device__ __forceinline__ void norm_phase(Ctx C, int l, int idx, int first) {
    refresh(C);
    const float* mod = (const float*)(C.ws + WS_MOD) + (size_t)l * 9 * 9216; bf16_t* XN = (bf16_t*)(C.ws + WS_XN);
    const float* gptr = inp(C, I_NG) + ((size_t)l * 3 + idx) * 1024;
    constexpr int NR = 4;
    for (int m0 = C.gw * NR; m0 < MT; m0 += C.NGW * NR) {
        f32x4 v[NR][4];
#pragma unroll
        for (int r = 0; r < NR; ++r) { const int m = m0 + r;
            const float* xr = first ? (m < MC ? inp(C, I_XP) + (size_t)m * DM : inp(C, I_XS) + (size_t)(m - MC) * DM) : C.out + (size_t)m * DM;
#pragma unroll
            for (int j = 0; j < 4; ++j) v[r][j] = ((const f32x4*)xr)[C.lane + 64 * j]; }
        const float* sh = mod + (size_t)cond_of_row(m0) * 9216 + (3 * idx) * 1024; const float* sc = sh + 1024;
        f32x4 gg[4], s1[4], s0[4];
#pragma unroll
        for (int j = 0; j < 4; ++j) { gg[j] = ((const f32x4*)gptr)[C.lane + 64 * j]; s1[j] = ((const f32x4*)sc)[C.lane + 64 * j] + 1.0f; s0[j] = ((const f32x4*)sh)[C.lane + 64 * j]; gg[j] = gg[j] * s1[j]; }
#pragma unroll
        for (int r = 0; r < NR; ++r) { const int m = m0 + r; float ss = 0.f;
#pragma unroll
            for (int j = 0; j < 4; ++j) ss += (v[r][j][0] * v[r][j][0] + v[r][j][1] * v[r][j][1]) + (v[r][j][2] * v[r][j][2] + v[r][j][3] * v[r][j][3]);
            const float rstd = 1.0f / sqrtf(wave_sum(ss, C.lane) * (1.0f / DM) + 1e-6f);
            u32x2* o = (u32x2*)(XN + (size_t)m * DM);
#pragma unroll
            for (int j = 0; j < 4; ++j) { const f32x4 y = v[r][j] * rstd * gg[j] + s0[j]; u32x2 w; w.x = cvt_pk_bf16(y[0], y[1]); w.y = cvt_pk_bf16(y[2], y[3]); o[C.lane + 64 * j] = w; } }
    }
}

__device__ __forceinline__ void unpack8(const u32x4 w, float* v) { v[0] = bflo(w.x); v[1] = bfhi(w.x); v[2] = bflo(w.y); v[3] = bfhi(w.y); v[4] = bflo(w.z); v[5] = bfhi(w.z); v[6] = bflo(w.w); v[7] = bfhi(w.w); }
__device__ __forceinline__ void normrope8(float* v, const float* g8, int c, bool lat, int prow, int pcol, int lane, const LAS f32x2* rt) {
    float ss = 0.f;
#pragma unroll
    for (int j = 0; j < 8; ++j) ss += v[j] * v[j];
    ss += shx(ss, 1, lane); ss += shx(ss, 2, lane); ss += shx(ss, 4, lane);
    const float rs = 1.0f / sqrtf(ss * (1.0f / 64.0f) + 1e-6f);
#pragma unroll
    for (int j = 0; j < 8; ++j) v[j] = v[j] * rs * g8[j];
    float pv[8];
#pragma unroll
    for (int j = 0; j < 8; ++j) pv[j] = shx(v[j], 2, lane);
    if (lat) { const int pos = (c < 4) ? prow : pcol;
#pragma unroll
        for (int j = 0; j < 8; ++j) { const f32x2 t = rt[pos * 16 + (c & 1) * 8 + j]; const float cs = t.x, sn = t.y;
            v[j] = ((c & 2) == 0) ? (v[j] * cs - pv[j] * sn) : (pv[j] * sn + v[j] * cs); } }
}
__device__ __forceinline__ void qkv_prep(Ctx C, int l, int wg_lo) {
    refresh(C);
    if (C.bx < wg_lo) return;
    C.gw -= wg_lo * 8; C.NGW -= wg_lo * 8;
    bf16_t* MIX = (bf16_t*)(C.ws + WS_MIX); const bf16_t* KVRAW = (const bf16_t*)(C.ws + WS_KVRAW); bf16_t* KN = (bf16_t*)(C.ws + WS_KN); bf16_t* VT = (bf16_t*)(C.ws + WS_VT);
    LAS f32x2* rt = (LAS f32x2*)C.lds;
    for (int i = C.tid; i < 1024; i += 512) rt[i] = ((const f32x2*)(C.ws + WS_ROPE))[i];
    __syncthreads();
    const int c = C.lane & 7;
    float qg[8], kg[8];
#pragma unroll
    for (int j = 0; j < 8; ++j) { qg[j] = inp(C, I_QG)[l * 64 + c * 8 + j]; kg[j] = inp(C, I_KG)[l * 64 + c * 8 + j]; }
    for (int m0 = C.gw * 4; m0 < MT; m0 += C.NGW * 4) {
      u32x4 qraw[4], kvraw[4];
#pragma unroll
      for (int r = 0; r < 4; ++r) { qraw[r] = *(const u32x4*)(MIX + (size_t)(m0 + r) * MIXW + C.lane * 8); kvraw[r] = *(const u32x4*)(KVRAW + (size_t)(m0 + r) * 256 + (C.lane & 31) * 8); }
#pragma unroll
      for (int r = 0; r < 4; ++r) { const int m = m0 + r;
        const bool lat = m >= MC; const int t = lat ? ((m - MC) & 2047) : (m & 255); const int prow = t >> 6, pcol = t & 63;
        { bf16_t* qp = MIX + (size_t)m * MIXW + C.lane * 8; float v[8]; unpack8(qraw[r], v);
          normrope8(v, qg, c, lat, prow, pcol, C.lane, rt);
          u32x4 w; w.x = cvt_pk_bf16(v[0], v[1]); w.y = cvt_pk_bf16(v[2], v[3]); w.z = cvt_pk_bf16(v[4], v[5]); w.w = cvt_pk_bf16(v[6], v[7]); *(u32x4*)qp = w; }
        { float v[8]; unpack8(kvraw[r], v);
          float raw[8];
#pragma unroll
          for (int j = 0; j < 8; ++j) raw[j] = v[j];
          float ss = 0.f;
#pragma unroll
          for (int j = 0; j < 8; ++j) ss += v[j] * v[j];
          ss += shx(ss, 1, C.lane); ss += shx(ss, 2, C.lane); ss += shx(ss, 4, C.lane);
          const float rs = 1.0f / sqrtf(ss * (1.0f / 64.0f) + 1e-6f);
          float kn[8];
#pragma unroll
          for (int j = 0; j < 8; ++j) kn[j] = v[j] * rs * kg[j];
          float pv[8];
#pragma unroll
          for (int j = 0; j < 8; ++j) pv[j] = shx(kn[j], 2, C.lane);
          if (!lat) { const int b = m >> 8; float* dst = C.out + (C.lane < 16 ? O_CK : O_CV) + (((size_t)(b * 2 + l) * 256 + t) * 128 + (C.lane & 15) * 8);
              if (C.lane < 16) { *(f32x4*)dst = (f32x4){kn[0], kn[1], kn[2], kn[3]}; *(f32x4*)(dst + 4) = (f32x4){kn[4], kn[5], kn[6], kn[7]}; }
              else if (C.lane < 32) { *(f32x4*)dst = (f32x4){raw[0], raw[1], raw[2], raw[3]}; *(f32x4*)(dst + 4) = (f32x4){raw[4], raw[5], raw[6], raw[7]}; } }
          else { const int pos = (c < 4) ? prow : pcol;
#pragma unroll
              for (int j = 0; j < 8; ++j) { const f32x2 t = rt[pos * 16 + (c & 1) * 8 + j]; const float cs = t.x, sn = t.y;
                  kn[j] = ((c & 2) == 0) ? (kn[j] * cs - pv[j] * sn) : (pv[j] * sn + kn[j] * cs); } }
          if (C.lane < 16) { u32x4 w; w.x = cvt_pk_bf16(kn[0], kn[1]); w.y = cvt_pk_bf16(kn[2], kn[3]); w.z = cvt_pk_bf16(kn[4], kn[5]); w.w = cvt_pk_bf16(kn[6], kn[7]);
              *(u32x4*)(KN + (size_t)m * 128 + C.lane * 8) = w; } }
      }
    }
    for (int task = C.NGW - 1 - C.gw; task < MT / 64; task += C.NGW) { const int r0 = task * 64, m = r0 + C.lane; const bool lat = r0 >= MC;
        const int b = lat ? ((r0 - MC) >> 11) : (r0 >> 8), t = lat ? ((m - MC) & 2047) : (m & 255); const size_t L = lat ? 2048 : 256;
        bf16_t* base = VT + (lat ? (size_t)MC * 128 : 0) + (size_t)b * 128 * L + t;
#pragma unroll 4
        for (int ch = 0; ch < 16; ++ch) { const u32x4 w = *(const u32x4*)(KVRAW + (size_t)m * 256 + 128 + ch * 8); bf16_t* p = base + (size_t)(ch * 8) * L;
            p[0] = (bf16_t)(w.x & 0xffff); p[L] = (bf16_t)(w.x >> 16); p[2 * L] = (bf16_t)(w.y & 0xffff); p[3 * L] = (bf16_t)(w.y >> 16);
            p[4 * L] = (bf16_t)(w.z & 0xffff); p[5 * L] = (bf16_t)(w.z >> 16); p[6 * L] = (bf16_t)(w.w & 0xffff); p[7 * L] = (bf16_t)(w.w >> 16); } }
    __syncthreads();
}

__device__ __forceinline__ void carry_phase(Ctx C, int l) {
    refresh(C);
    const f32x2* P = (const f32x2*)(C.ws + WS_PTAB); const float* SEND = (const float*)(C.ws + WS_SEND); bf16_t* AC = (bf16_t*)(C.ws + WS_AC);
    for (int task = C.gw; task < 256 + 1024; task += C.NGW) {
        const bool lat = task < 256; const int id = (lat ? task : task - 256) * 64 + C.lane;
        const int p = id & 63, r = (id >> 6) & 1, g = (id >> 7) & 15, b = id >> 11;
        const int nc = lat ? 64 : 8, chunk0 = lat ? 256 + b * 64 : b * 8;
        const f32x2 lt = P[((size_t)((l * 2 + r) * 16 + g) * 64 + p) * 34 + 32];
        float sr = 0.f, si = 0.f;
        if (lat) { const size_t hi = ((size_t)((b * 2 + l) * 2 + r) * 16 + g) * 64 + p; sr = inp(C, I_SRE)[hi]; si = inp(C, I_SIM)[hi]; }
        const float* se = SEND + ((size_t)g * 768 + chunk0) * 256 + r * 128 + p; bf16_t* ac = AC + ((size_t)g * 768 + chunk0) * 768 + 512 + r * 128 + p;
#pragma unroll 16
        for (int cc = 0; cc < nc; ++cc) { const int ci = r == 0 ? cc : nc - 1 - cc;
            const float er = se[(size_t)ci * 256], ei = se[(size_t)ci * 256 + 64];
            ac[(size_t)ci * 768] = (bf16_t)(cvt_pk_bf16(sr, sr) & 0xffff); ac[(size_t)ci * 768 + 64] = (bf16_t)(cvt_pk_bf16(si, si) & 0xffff);
            const float nr = lt.x * sr - lt.y * si + er, ni = lt.x * si + lt.y * sr + ei; sr = nr; si = ni; }
        if (!lat) { const size_t oi = ((size_t)((b * 2 + l) * 2 + r) * 16 + g) * 64 + p; C.out[O_SRE + oi] = sr; C.out[O_SIM + oi] = si; }
    }
}

__device__ __forceinline__ void attn_phase(Ctx C, int l, int dummy_out = 0) {
    refresh(C);
    bf16_t* MIX = (bf16_t*)(C.ws + WS_MIX); const bf16_t* KN = (const bf16_t*)(C.ws + WS_KN); const bf16_t* VT = (const bf16_t*)(C.ws + WS_VT);
    const bf16_t* KC = (const bf16_t*)(C.ws + WS_KC) + (size_t)l * 8 * 256 * 128; const bf16_t* VTC = (const bf16_t*)(C.ws + WS_VTC) + (size_t)l * 8 * 128 * 256;
    LAS unsigned char* Ks = C.lds; LAS unsigned char* Vs = C.lds + 64 * 144;
    const int lane = C.lane, wid = C.wid, l15 = lane & 15, q4 = lane >> 4, gq = wid >> 1, half = wid & 1;
    const int sr_ = C.tid >> 3, sc_ = C.tid & 7;
    const float SC = 0.125f * 1.4426950408889634f;
    for (int u0 = C.bx; u0 < 768; u0 += C.G) {
        int u = u0;
        if (C.G == 256) { const int x = u0 & 7, s = (u0 >> 3) & 31, rnd = u0 >> 8;
            if (rnd < 2) u = ((rnd * 8 + x) << 5) + s;
            else u = 512 + ((((s >> 2) * 8 + x) << 2) | (s & 3)); }
        const bool lat = u < 512; int b, hk, qb; if (lat) { b = u >> 6; hk = (u >> 5) & 1; qb = u & 31; } else { const int v = u - 512; b = v >> 3; hk = (v >> 2) & 1; qb = v & 3; }
        const int rowbase = lat ? MC + b * 2048 : b * 256;
        const int lt_lo = lat ? (qb - 2 < 0 ? 0 : qb - 2) : 0, lt_hi = lat ? (qb + 2 > 31 ? 31 : qb + 2) : 3;
        const int nctx = lat ? 4 : 0, nT = nctx + (lt_hi - lt_lo + 1);
        const int h = hk * 4 + gq, qrow0 = rowbase + qb * 64 + half * 32;
        const float sink2 = inp(C, I_SINK)[l * 8 + h] * 1.4426950408889634f;
        bf16x8 Qf[2][2];
#pragma unroll
        for (int qt = 0; qt < 2; ++qt)
#pragma unroll
            for (int ds = 0; ds < 2; ++ds) Qf[qt][ds] = *(const bf16x8*)(MIX + (size_t)(qrow0 + qt * 16 + l15) * MIXW + h * 64 + ds * 32 + q4 * 8);
        f32x4 ot[4][2];
#pragma unroll
        for (int dt = 0; dt < 4; ++dt)
#pragma unroll
            for (int qt = 0; qt < 2; ++qt) ot[dt][qt] = (f32x4){0.f, 0.f, 0.f, 0.f};
        float mrun[2] = {sink2, sink2}, lrun[2] = {q4 == 0 ? 1.f : 0.f, q4 == 0 ? 1.f : 0.f};
        u32x4 kreg, vreg;
#define ATT_LOAD(tt) do { const int t_ = (tt); const bf16_t* kp; const bf16_t* vp; size_t vpitch; \
            if (t_ < nctx) { kp = KC + ((size_t)b * 256 + 64 * t_) * 128 + hk * 64; vp = VTC + (size_t)(b * 2 + hk) * 64 * 256 + 64 * t_; vpitch = 256; } \
            else { const int lt_ = lt_lo + (t_ - nctx); kp = KN + ((size_t)rowbase + 64 * lt_) * 128 + hk * 64; \
                   if (lat) { vp = VT + (size_t)MC * 128 + (size_t)(b * 2 + hk) * 64 * 2048 + 64 * lt_; vpitch = 2048; } else { vp = VT + (size_t)(b * 2 + hk) * 64 * 256 + 64 * lt_; vpitch = 256; } } \
            kreg = *(const u32x4*)(kp + (size_t)sr_ * 128 + sc_ * 8); vreg = *(const u32x4*)(vp + (size_t)sr_ * vpitch + sc_ * 8); } while (0)
        ATT_LOAD(0);
        for (int t = 0; t < nT; ++t) {
            *(LAS u32x4*)(Ks + sr_ * 144 + sc_ * 16) = kreg; *(LAS u32x4*)(Vs + sr_ * 144 + sc_ * 16) = vreg;
            __syncthreads();
            if (t + 1 < nT) ATT_LOAD(t + 1);
            f32x4 st[4][2];
#pragma unroll
            for (int kt = 0; kt < 4; ++kt) {
#pragma unroll
                for (int qt = 0; qt < 2; ++qt) st[kt][qt] = (f32x4){0.f, 0.f, 0.f, 0.f};
#pragma unroll
                for (int ds = 0; ds < 2; ++ds) { const bf16x8 Kf = *(const LAS bf16x8*)(Ks + (kt * 16 + l15) * 144 + (ds * 32 + q4 * 8) * 2);
#pragma unroll
                    for (int qt = 0; qt < 2; ++qt) st[kt][qt] = __builtin_amdgcn_mfma_f32_16x16x32_bf16(Kf, Qf[qt][ds], st[kt][qt], 0, 0, 0); } }
            int mtype = 0, ltile = 0; if (t >= nctx && lat) { ltile = lt_lo + (t - nctx); mtype = (ltile == qb - 2 || ltile == qb + 2) ? 1 : 0; }
            bf16x8 pb[2][2];
#pragma unroll
            for (int qt = 0; qt < 2; ++qt) {
                const int qp = qb * 64 + half * 32 + qt * 16 + l15;
                float mx = -INFINITY;
#pragma unroll
                for (int kt = 0; kt < 4; ++kt)
#pragma unroll
                    for (int i = 0; i < 4; ++i) { float tv = st[kt][qt][i] * SC;
                        if (mtype) { const int kp_ = ltile * 64 + kt * 16 + q4 * 4 + i; const int d = kp_ - qp; if (d > 128 || d < -128) tv = -INFINITY; }
                        st[kt][qt][i] = tv; mx = fmaxf(mx, tv); }
                mx = fmaxf(mx, shx(mx, 16, lane)); mx = fmaxf(mx, shx(mx, 32, lane));
                const float mnew = fmaxf(mrun[qt], mx), alpha = __builtin_amdgcn_exp2f(mrun[qt] - mnew); mrun[qt] = mnew;
                float ls = 0.f;
#pragma unroll
                for (int kt = 0; kt < 4; ++kt)
#pragma unroll
                    for (int i = 0; i < 4; ++i) { const float pv = __builtin_amdgcn_exp2f(st[kt][qt][i] - mnew); st[kt][qt][i] = pv; ls += pv; }
                lrun[qt] = lrun[qt] * alpha + ls;
#pragma unroll
                for (int dt = 0; dt < 4; ++dt) ot[dt][qt] = ot[dt][qt] * alpha;
#pragma unroll
                for (int ks = 0; ks < 2; ++ks) { const u32x4 w = pack8(st[2 * ks][qt], st[2 * ks + 1][qt]); pb[ks][qt] = __builtin_bit_cast(bf16x8, w); }
            }
#pragma unroll
            for (int ks = 0; ks < 2; ++ks)
#pragma unroll
                for (int dt = 0; dt < 4; ++dt) { const LAS unsigned char* vb = Vs + (dt * 16 + l15) * 144 + (32 * ks + q4 * 4) * 2;
                    const u32x2 v0 = *(const LAS u32x2*)vb, v1 = *(const LAS u32x2*)(vb + 32); const u32x4 vv = {v0.x, v0.y, v1.x, v1.y}; const bf16x8 Vf = __builtin_bit_cast(bf16x8, vv);
#pragma unroll
                    for (int qt = 0; qt < 2; ++qt) ot[dt][qt] = __builtin_amdgcn_mfma_f32_16x16x32_bf16(Vf, pb[ks][qt], ot[dt][qt], 0, 0, 0); }
            __syncthreads();
        }
#undef ATT_LOAD
#pragma unroll
        for (int qt = 0; qt < 2; ++qt) { float lsum = lrun[qt]; lsum += shx(lsum, 16, lane); lsum += shx(lsum, 32, lane); const float inv = 1.0f / lsum;
            bf16_t* op = dummy_out ? (bf16_t*)(C.ws + WS_XN) + (size_t)(qrow0 + qt * 16 + l15) * 1024 + h * 64 + q4 * 4 : MIX + (size_t)(qrow0 + qt * 16 + l15) * MIXW + h * 64 + q4 * 4;
#pragma unroll
            for (int dt = 0; dt < 4; ++dt) { const f32x4 o = ot[dt][qt] * inv; u32x2 w; w.x = cvt_pk_bf16(o[0], o[1]); w.y = cvt_pk_bf16(o[2], o[3]); *(u32x2*)(op + dt * 16) = w; } }
    }
}


#define XB_TMO      128
#define XB_XCNT(j)  (256  + 64 * (j))
#define XB_XSUB(j)  (1280 + 64 * (j))
#define XB_XGEN(j)  (2304 + 64 * (j))
#define XB_TOP      3328
#define XB_TOPGEN   3392
#define XCD_BAR_WORDS 3456
#define XB_SPIN_CAP (1u << 20)
__device__ __forceinline__ unsigned xb_ld(unsigned* p)              { return __hip_atomic_load(p, __ATOMIC_RELAXED, __HIP_MEMORY_SCOPE_AGENT); }
__device__ __forceinline__ unsigned xb_add(unsigned* p, unsigned v) { return __hip_atomic_fetch_add(p, v, __ATOMIC_RELAXED, __HIP_MEMORY_SCOPE_AGENT); }
__device__ __forceinline__ unsigned xb_xcc_id() { return (unsigned)__builtin_amdgcn_s_getreg((3 << 11) | 20) & 0xFu; }
#define XB_SPIN(cond, bar) do { unsigned _sp = 0; while (cond) { __builtin_amdgcn_s_sleep(1); \
    if ((++_sp & 255u) == 0u) { if (xb_ld(&(bar)[XB_TMO])) break; if (_sp > XB_SPIN_CAP) { atomicAdd(&(bar)[XB_TMO], 1u); break; } } } } while (0)
struct XcdBarrier { unsigned* bar; unsigned x; volatile LAS unsigned* st; };
__device__ __forceinline__ XcdBarrier xcd_barrier_post(unsigned* bar, volatile LAS unsigned* st, int tid) {
    XcdBarrier b; b.bar = bar; b.x = xb_xcc_id(); b.st = st;
    if (tid == 0) (void)xb_add(&bar[XB_XCNT(b.x)], 1u);
    return b;
}
__device__ __forceinline__ void xcd_barrier_complete(unsigned* bar, unsigned x, unsigned& nloc, unsigned& nx) {
    const unsigned G = gridDim.x * gridDim.y * gridDim.z;
    unsigned sum, cnt, mine, sp = 0u;
    for (;;) {
        sum = 0u; cnt = 0u; mine = 0u;
#pragma unroll
        for (unsigned j = 0; j < 16; ++j) { const unsigned c = xb_ld(&bar[XB_XCNT(j)]); sum += c; cnt += (c > 0u) ? 1u : 0u; mine = (j == x) ? c : mine; }
        if (sum == G) break;
        __builtin_amdgcn_s_sleep(1);
        if ((++sp & 255u) == 0u) { if (xb_ld(&bar[XB_TMO])) break; if (sp > XB_SPIN_CAP) { atomicAdd(&bar[XB_TMO], 1u); break; } }
    }
    nloc = mine > 0u ? mine : 1u; nx = cnt > 0u ? cnt : 1u;
}
__device__ __forceinline__ void xcd_barrier(const XcdBarrier& b, int tid) {
    asm volatile("s_waitcnt vmcnt(0)" ::: "memory");
    __syncthreads();
    if (tid == 0) {
        unsigned* bar = b.bar;
        __builtin_amdgcn_s_waitcnt(0);
        unsigned nloc = b.st[0], nx = b.st[1];
        if (nloc == 0u) { xcd_barrier_complete(bar, b.x, nloc, nx); b.st[0] = nloc; b.st[1] = nx; }
        const unsigned old = xb_add(&bar[XB_XSUB(b.x)], 1u);
        const unsigned gen = old / nloc;
        if (old + 1u == (gen + 1u) * nloc) {
            __builtin_amdgcn_fence(__ATOMIC_RELEASE, "agent");
            asm volatile("s_waitcnt vmcnt(0)" ::: "memory");
            const unsigned og = xb_add(&bar[XB_TOP], 1u);
            const unsigned tg = og / nx;
            if (og + 1u == (tg + 1u) * nx) xb_add(&bar[XB_TOPGEN], 1u);
            else XB_SPIN(xb_ld(&bar[XB_TOPGEN]) == tg, bar);
            __builtin_amdgcn_fence(__ATOMIC_ACQUIRE, "agent");
            xb_add(&bar[XB_XGEN(b.x)], 1u);
            asm volatile("s_waitcnt vmcnt(0)" ::: "memory");
        } else {
            XB_SPIN(xb_ld(&bar[XB_XGEN(b.x)]) == gen, bar);
            __builtin_amdgcn_fence(__ATOMIC_ACQUIRE, "agent");
            asm volatile("s_waitcnt vmcnt(0)" ::: "memory");
        }
    }
    __syncthreads();
}
#ifndef PROBE
#define PROBE 0
#endif
#define GSYNC() do { Ctx B_ = C; refresh(B_); xcd_barrier(xb, B_.tid); if (PROBE == 1) xcd_barrier(xb, B_.tid); } while (0)
#ifndef PHMASK
#define PHMASK 0xffff
#endif
#define PH(b) if constexpr ((PHMASK >> (b)) & 1)
template <int l> __device__ __forceinline__ void mix_block(Ctx& C, const XcdBarrier& xb) {
                PH(3) norm_phase(C, l, 1, 0);
                if (PROBE == 4) norm_phase(C, l, 1, 0);
                GSYNC();
                PH(5) { Ctx D = C; refresh(D); unsigned char* ws = D.ws; const int G = D.G, bx = D.bx; pg8::Sched S; S.init(ws + WS_XN, ws + WS_WINT + (size_t)l * 1280 * 1024 * 2, 96, 5, 1, (size_t)256 * 1024 * 2, (size_t)256 * 1024 * 2, 0, 0, G, bx);
                  pg8::EpiWin E{(bf16_t*)(ws + WS_MIX), (bf16_t*)(ws + WS_KVRAW), (bf16_t*)(ws + WS_UT), (bf16_t*)(ws + WS_AC)};
                  pg8::gemm_phase(D.lds, D.tid, 1024, 1024, 1024, S, E); }
                GSYNC();
                PH(6) qkv_prep(C, l, C.G >= 224 ? 112 : 0);
                PH(7) { Ctx D = C; refresh(D); unsigned char* ws = D.ws; const int G = D.G, bx = D.bx; pg8::Sched S; S.init(ws + WS_DFTC, ws + WS_UT, 2, 1, 32, (size_t)256 * 256 * 2, 0, 0, (size_t)256 * 256 * 2, G, bx);
                  pg8::EpiDFT<0> E{(bf16_t*)(ws + WS_MIX)}; pg8::gemm_phase(D.lds, D.tid, 256, 256, 256, S, E); }
                PH(8) { Ctx D = C; refresh(D); unsigned char* ws = D.ws; const int G = D.G, bx = D.bx; pg8::Sched S; S.init(ws + WS_AC, ws + WS_WAT + (size_t)l * 16 * 256 * 512 * 2, 3, 1, 16, (size_t)256 * 768 * 2, 0, (size_t)768 * 768 * 2, (size_t)256 * 512 * 2, G, (bx + G - 64 % G) % G);
                  pg8::EpiSsmA E{(float*)(ws + WS_SEND)}; pg8::gemm_phase(D.lds, D.tid, 768, 512, 512, S, E); }
                GSYNC();
                if (PROBE == 2) attn_phase(C, l, 1);
                PH(9) attn_phase(C, l);
                PH(10) carry_phase(C, l);
                if (PROBE == 8) carry_phase(C, l);
                GSYNC();
                PH(11) { Ctx D = C; refresh(D); unsigned char* ws = D.ws; const int G = D.G, bx = D.bx; pg8::Sched S; S.init(ws + WS_AC, ws + WS_MTT + (size_t)l * 16 * 512 * 768 * 2, 3, 2, 16, (size_t)256 * 768 * 2, (size_t)256 * 768 * 2, (size_t)768 * 768 * 2, (size_t)512 * 768 * 2, G, bx);
                  pg8::EpiSsmC E{(bf16_t*)(ws + WS_Y)}; pg8::gemm_phase(D.lds, D.tid, 768, 768, 768, S, E); if (PROBE == 8) pg8::gemm_phase(D.lds, D.tid, 768, 768, 768, S, E); }
                PH(7) { Ctx D = C; refresh(D); unsigned char* ws = D.ws; const int G = D.G, bx = D.bx; pg8::Sched S; S.init(ws + WS_DFTL, ws + WS_UT + (size_t)MC * 256 * 2, 8, 2, 8, (size_t)256 * 1024 * 2, (size_t)256 * 1024 * 2, 0, (size_t)512 * 1024 * 2, G, (bx + G - 96 % G) % G);
                  pg8::EpiDFT2 E{(bf16_t*)(ws + WS_MIX), (const f32x2*)(ws + WS_TWID)}; pg8::gemm_phase(D.lds, D.tid, 1024, 1024, 1024, S, E); }
                GSYNC();
                PH(12) { Ctx D = C; refresh(D); unsigned char* ws = D.ws; const int G = D.G, bx = D.bx; pg8::Sched S; S.init(ws + WS_Y, ws + WS_WGLUT + (size_t)l * 512 * 256 * 2, 96, 2, 1, (size_t)256 * 256 * 2, (size_t)256 * 256 * 2, 0, 0, G, bx);
                  pg8::EpiGated<1> E{(bf16_t*)(ws + WS_MIX) + 1024, MIXW}; pg8::gemm_phase(D.lds, D.tid, 256, 256, 256, S, E); if (PROBE == 8) pg8::gemm_phase(D.lds, D.tid, 256, 256, 256, S, E); }
                GSYNC();
                PH(13) { Ctx D = C; refresh(D); unsigned char* ws = D.ws; const int G = D.G, bx = D.bx; pg8::Sched S; S.init(ws + WS_MIX, ws + WS_WOUTT + (size_t)l * 1024 * 1280 * 2, 96, 4, 1, (size_t)256 * 1280 * 2, (size_t)256 * 1280 * 2, 0, 0, G, bx);
                  pg8::EpiResidT<2, 0> E{D.out, (const float*)(ws + WS_MOD) + (size_t)l * 9 * 9216 + 5 * 1024, D.out}; pg8::gemm_phase(D.lds, D.tid, 1280, 1280, 1280, S, E); }
                GSYNC();
                PH(3) norm_phase(C, l, 2, 0);
                if (PROBE == 4) norm_phase(C, l, 2, 0);
                GSYNC();
}
template <int l, int f> __device__ __forceinline__ void ffn_block(Ctx& C, const XcdBarrier& xb) {
    constexpr size_t W13 = WS_W13T + (size_t)(l * 2 + f) * 5632 * 1024 * 2, W2 = WS_W2T + (size_t)(l * 2 + f) * 1024 * 2816 * 2;
    constexpr size_t GOFF = (size_t)l * 9 * 9216 + (f == 0 ? 2 : 8) * 1024;
    PH(14) { Ctx D = C; refresh(D); unsigned char* ws = D.ws; const int G = D.G, bx = D.bx; pg8::Sched S; S.init(ws + WS_XN, ws + W13, 32, 22, 1, (size_t)256 * 1024 * 2, (size_t)256 * 1024 * 2, 0, 0, G, bx);
      pg8::EpiGated<0> E{(bf16_t*)(ws + WS_HID), FF}; pg8::gemm_phase(D.lds, D.tid, 1024, 1024, 1024, S, E); }
    GSYNC();
    PH(15) { Ctx D = C; refresh(D); unsigned char* ws = D.ws; const int G = D.G, bx = D.bx, H = G / 2; pg8::Sched S; S.init(ws + WS_HID, ws + W2, 32, 4, 1, (size_t)256 * 2816 * 2, (size_t)256 * 2816 * 2, 0, 0, G, bx);
      S.range(0, 128, H, bx < H ? bx : -1, 0);
      pg8::EpiResidT<2, 1> E{D.out, (const float*)(ws + WS_MOD) + GOFF, (l == 0 && f == 0) ? inp(D, I_XP) : (const float*)D.out}; pg8::gemm_phase(D.lds, D.tid, 2816, 2816, 2816, S, E); }
    PH(14) { Ctx D = C; refresh(D); unsigned char* ws = D.ws; const int G = D.G, bx = D.bx, H = G / 2; pg8::Sched S; S.init(ws + WS_XN, ws + W13, 64, 22, 1, (size_t)256 * 1024 * 2, (size_t)256 * 1024 * 2, 0, 0, G, bx);
      if (bx < H) S.range(896, 1408, H, bx, 32); else S.range(0, 896, H, bx - H, 32);
      pg8::EpiGated<0> E{(bf16_t*)(ws + WS_HID), FF}; pg8::gemm_phase(D.lds, D.tid, 1024, 1024, 1024, S, E); }
    GSYNC();
    PH(15) { Ctx D = C; refresh(D); unsigned char* ws = D.ws; const int G = D.G, bx = D.bx; pg8::Sched S; S.init(ws + WS_HID, ws + W2, 64, 4, 1, (size_t)256 * 2816 * 2, (size_t)256 * 2816 * 2, 0, 0, G, bx);
      S.range(0, 256, G, bx, 32);
      pg8::EpiResidT<2, 1> E{D.out, (const float*)(ws + WS_MOD) + GOFF, (l == 0 && f == 0) ? inp(D, I_XS) - (size_t)MC * DM : (const float*)D.out}; pg8::gemm_phase(D.lds, D.tid, 2816, 2816, 2816, S, E); }
    if (l == 0 && f == 0) { p1_tables(C, 0); }
    GSYNC();
    if (l == 0 && f == 0) { p2_tables(C, 0); }
}
template <int l> __device__ __forceinline__ void layer_fwd(Ctx& C, const XcdBarrier& xb) {
    { Ctx D = C; refresh(D); unsigned char* ws = D.ws; const int G = D.G, bx = D.bx; pg8::Sched S; S.init(ws + WS_TW + (size_t)l * 512 * 256 * 2, ws + WS_WOFT + (size_t)l * 1024 * 256 * 2, 2, 4, 1, (size_t)256 * 256 * 2, (size_t)256 * 256 * 2, 0, 0, G, bx);
      pg8::EpiFold E{(bf16_t*)(ws + WS_WOUTT) + (size_t)l * 1024 * 1280}; pg8::gemm_phase(D.lds, D.tid, 256, 256, 256, S, E); }
    PH(3) norm_phase(C, l, 0, l == 0);
    if (PROBE == 4) norm_phase(C, l, 0, l == 0);
    GSYNC();
    ffn_block<l, 0>(C, xb);
    mix_block<l>(C, xb);
    ffn_block<l, 1>(C, xb);
}
__global__ void __launch_bounds__(512, 2) fwd_kernel(Args a) {
    extern __shared__ __attribute__((aligned(16))) unsigned char lds_raw[];
    cg::grid_group grid = cg::this_grid();
    Ctx C; C.out = a.out; C.ws = a.ws; C.wid0 = __builtin_amdgcn_readfirstlane((int)threadIdx.x >> 6);
    C.lds = (LAS unsigned char*)lds_raw;
    if (threadIdx.x == 0) {
#pragma unroll
        for (int i = 0; i < N_IN; ++i) *(const float* LAS*)(C.lds + PTR_OFF + i * 8) = a.in[i];
    }
    if (threadIdx.x < 2) *(volatile LAS unsigned*)(C.lds + PTR_OFF + 256 + threadIdx.x * 4) = 0u;
    if (blockIdx.x == 0) { for (int i = threadIdx.x; i < 3456; i += 512) ((unsigned*)(a.ws + WS_BAR))[i] = 0u; }
    __syncthreads();
    refresh(C);

    PH(0) p0_mod(C);
    PH(1) p0_weights(C, 0, 2, 0);
    PH(2) p0_tables(C);
    if (PROBE == 3) { p0_mod(C); p0_weights(C, 0, 1, 0); p0_tables(C); }
    grid.sync();
    XcdBarrier xb;
    { Ctx B_ = C; refresh(B_); xb = xcd_barrier_post((unsigned*)(B_.ws + WS_BAR), (volatile LAS unsigned*)(C.lds + PTR_OFF + 256), B_.tid); }

    layer_fwd<0>(C, xb);
    layer_fwd<1>(C, xb);
}

extern "C" void kernel_launch(void* const* d_in, const int* in_sizes, int n_in, void* d_out, int out_size, void* d_ws, size_t ws_size, hipStream_t stream) {
    static int grid = 0;
    if (grid == 0) {
        if (n_in != N_IN || ws_size < WS_TOTAL) { fprintf(stderr, "kernel_launch: need %d inputs and %zu bytes of workspace; got %d, %zu\n", (int)N_IN, (size_t)WS_TOTAL, n_in, ws_size); grid = -1; return; }
        int dev = 0, cus = 0, per_cu = 0;
        (void)hipGetDevice(&dev); (void)hipDeviceGetAttribute(&cus, hipDeviceAttributeMultiprocessorCount, dev);
        if (hipFuncSetAttribute((const void*)fwd_kernel, hipFuncAttributeMaxDynamicSharedMemorySize, LDS_BYTES) != hipSuccess) { fprintf(stderr, "kernel_launch: hipFuncSetAttribute failed\n"); grid = -1; return; }
        if (hipOccupancyMaxActiveBlocksPerMultiprocessor(&per_cu, (const void*)fwd_kernel, 512, LDS_BYTES) != hipSuccess || per_cu < 1) per_cu = 1;
        (void)hipGetLastError();
        grid = cus * per_cu;
        if (grid <= 0) { grid = -1; return; }
    }
    if (grid < 0) return;
    Args a{};
    for (int i = 0; i < N_IN; ++i) a.in[i] = (const float*)d_in[i];
    a.out = (float*)d_out; a.ws = (unsigned char*)d_ws;
    void* args[] = {&a};
    hipError_t e = hipLaunchCooperativeKernel((const void*)fwd_kernel, dim3(grid), dim3(512), args, LDS_BYTES, stream);
    if (e != hipSuccess) fprintf(stderr, "cooperative launch failed: %s (grid %d)\n", hipGetErrorString(e), grid);
}
```

```cpp
#include <hip/hip_runtime.h>
#include <hip/hip_cooperative_groups.h>
#include <cstdio>
#include <cstdint>
#include <cmath>
namespace cg = cooperative_groups;

#define LAS __attribute__((address_space(3)))
typedef unsigned short bf16_t;
typedef short bf16x8 __attribute__((ext_vector_type(8)));
typedef float f32x4 __attribute__((ext_vector_type(4)));
typedef float f32x2 __attribute__((ext_vector_type(2)));
typedef unsigned u32x4 __attribute__((ext_vector_type(4)));
typedef unsigned u32x2 __attribute__((ext_vector_type(2)));

constexpr int DM = 1024, FF = 2816, MC = 8192, MT = 24576;
constexpr int MIXW = 1280;
constexpr size_t O_CK = 25165824, O_CV = 27262976, O_SRE = 29360128, O_SIM = 29491200;
enum { I_XP = 0, I_XS, I_CK, I_CV, I_SRE, I_SIM, I_C, I_CCTX, I_WMOD, I_BMOD, I_NG, I_W1, I_W3, I_W2, I_WIN, I_WOUT, I_QG, I_KG, I_SINK, I_WF,
       I_LRE, I_LIM, I_BRE, I_BIM, I_CRE, I_CIM, I_SD, I_LS, I_GLU, N_IN };

constexpr size_t al(size_t x) { return (x + 255) & ~(size_t)255; }
constexpr size_t WS_MOD = 0;
constexpr size_t WS_PTAB = WS_MOD + al((size_t)2 * 9 * 9216 * 4);
constexpr size_t WS_KTAB = WS_PTAB + al((size_t)2 * 2 * 16 * 64 * 34 * 8);
constexpr size_t WS_G = WS_KTAB + al((size_t)2 * 16 * 2 * 32 * 256 * 4);
constexpr size_t WS_TW = WS_G, WS_WOFT = WS_G + (size_t)2 * 512 * 256 * 2, WS_ROPE = WS_WOFT + (size_t)2 * 1024 * 256 * 2, WS_TWID = WS_ROPE + 8192;
constexpr size_t WS_W13T = WS_G + al((size_t)2 * 256 * 1024 * 4);
constexpr size_t WS_W2T = WS_W13T + al((size_t)4 * 5632 * 1024 * 2);
constexpr size_t WS_WINT = WS_W2T + al((size_t)4 * 1024 * 2816 * 2);
constexpr size_t WS_WOUTT = WS_WINT + al((size_t)2 * 1280 * 1024 * 2);
constexpr size_t WS_WGLUT = WS_WOUTT + al((size_t)2 * 1024 * 1280 * 2);
constexpr size_t WS_DFTL = WS_WGLUT + al((size_t)2 * 512 * 256 * 2);
constexpr size_t WS_DFTC = WS_DFTL + al((size_t)4096 * 2048 * 2);
constexpr size_t WS_MTT = WS_DFTC + al((size_t)512 * 256 * 2);
constexpr size_t WS_WAT = WS_MTT + al((size_t)2 * 16 * 512 * 768 * 2);
constexpr size_t WS_KC = WS_WAT + al((size_t)2 * 16 * 256 * 512 * 2);
constexpr size_t WS_VTC = WS_KC + al((size_t)2 * 8 * 256 * 128 * 2);
constexpr size_t WS_XN = WS_VTC + al((size_t)2 * 8 * 2 * 64 * 256 * 2);
constexpr size_t WS_BIG = WS_XN + al((size_t)MT * 1024 * 2);
constexpr size_t WS_HID = WS_BIG;
constexpr size_t WS_MIX = WS_BIG;
constexpr size_t WS_KVRAW = WS_MIX + al((size_t)MT * 1280 * 2);
constexpr size_t WS_Y = WS_KVRAW;
constexpr size_t WS_KN = WS_KVRAW + al((size_t)MT * 256 * 2);
constexpr size_t WS_VT = WS_KN + al((size_t)MT * 128 * 2);
constexpr size_t WS_UT = WS_VT + al((size_t)MT * 128 * 2);
constexpr size_t WS_AC = WS_UT + al((size_t)MT * 256 * 2);
constexpr size_t WS_SEND = WS_AC + al((size_t)16 * 768 * 768 * 2);
constexpr size_t WS_MIXEND = WS_SEND + al((size_t)16 * 768 * 256 * 4);
constexpr size_t WS_END = WS_BIG + al((size_t)MT * 2816 * 2);
constexpr size_t WS_BAR = WS_END;
constexpr size_t WS_TOTAL = WS_BAR + 16384;
static_assert(WS_MIXEND <= WS_END, "mixer buffers must fit in the HID overlay");

constexpr int LDS_BYTES = 147456;

__device__ __forceinline__ unsigned cvt_pk_bf16(float lo, float hi) { unsigned r; asm volatile("v_cvt_pk_bf16_f32 %0, %1, %2" : "=v"(r) : "v"(lo), "v"(hi)); return r; }
__device__ __forceinline__ float bf2f(unsigned short b) { return __uint_as_float(((unsigned)b) << 16); }
__device__ __forceinline__ float bflo(unsigned w) { return __uint_as_float(w << 16); }
__device__ __forceinline__ float bfhi(unsigned w) { return __uint_as_float(w & 0xffff0000u); }
__device__ __forceinline__ float sigmoidf_(float x) { return __builtin_amdgcn_rcpf(1.0f + __builtin_amdgcn_exp2f(x * -1.4426950408889634f)); }
__device__ __forceinline__ float gelu_tanh(float x) { const float u = 1.5957691216f * (x + 0.044715f * x * x * x); return x * __builtin_amdgcn_rcpf(1.0f + __builtin_amdgcn_exp2f(u * -1.4426950408889634f)); }
__device__ __forceinline__ int cond_of_row(int m) { return m < MC ? 0 : 1 + ((m - MC) >> 11); }

namespace pg8 {
constexpr int BM = 256, BK = 64, HALF = 128, HTB = HALF * BK * 2, STAGE_BYTES = 8 * HTB, NXCD = 8, WGM = 4;
__host__ __device__ __forceinline__ int lds_byte(int r, int c) { const int st = (r >> 4) * 2 + (c >> 5), rr = r & 15, cc = c & 31, ob = rr * 64 + cc * 2; return st * 1024 + (ob ^ (((ob >> 9) & 1) << 5)); }
__host__ __device__ __forceinline__ void stage_rc(int b, int& R, int& C) { const int st = b / 1024, sb = b % 1024, swz = sb ^ (((sb >> 9) & 1) << 5); R = (st >> 1) * 16 + swz / 64; C = (st & 1) * 32 + (swz % 64) / 2; }
__host__ __device__ __forceinline__ int perm32(int rho) { const int n = rho >> 4, i = rho & 15; return 8 * (i >> 2) + 4 * n + (i & 3); }

struct Unit { const char* a; const char* b; int pm, pn, z; };

struct Sched {
    const char* A; const char* B; size_t aTile, bTile, aZ, bZ; int nM, nN, nwg, total, G, c, Lofs, pm0;
    __device__ __forceinline__ void init(const void* A_, const void* B_, int nM_, int nN_, int nZ_, size_t aTile_, size_t bTile_, size_t aZ_, size_t bZ_, int G_, int c_) {
        A = (const char*)A_; B = (const char*)B_; nM = nM_; nN = nN_; nwg = nM_ * nN_; total = nwg * nZ_; aTile = aTile_; bTile = bTile_; aZ = aZ_; bZ = bZ_; G = G_; c = c_; Lofs = 0; pm0 = 0; }
    __device__ __forceinline__ void range(int lo, int hi, int G_, int c_, int pm0_) { Lofs = lo; total = c_ < 0 ? lo : hi; G = G_; c = c_ < 0 ? 0 : c_; pm0 = pm0_; }
    __device__ __forceinline__ bool next(int i, Unit& u) const {
        const long L = (long)Lofs + (long)i * G + c; if (L >= total) return false;
        const int z = (int)(L / nwg); int wgid = (int)(L % nwg);
        { const int q = nwg / NXCD, r = nwg % NXCD, xcd = wgid % NXCD, off = wgid / NXCD; wgid = (xcd < r ? xcd * (q + 1) : r * (q + 1) + (xcd - r) * q) + off; }
        const int nig = WGM * nN, gid = wgid / nig, fm = gid * WGM, gsz = (nM - fm) < WGM ? (nM - fm) : WGM;
        u.pm = pm0 + fm + ((wgid % nig) % gsz); u.pn = (wgid % nig) / gsz; u.z = z;
        u.a = A + (size_t)z * aZ + (size_t)u.pm * aTile; u.b = B + (size_t)z * bZ + (size_t)u.pn * bTile; return true;
    }
};

template <class Epi>
__device__ __forceinline__ void gemm_phase(LAS unsigned char* lds, const int tid_in, const int ldA, const int ldB, const int K, const Sched& S, const Epi& E) {
    int tid_ = tid_in; asm volatile("" : "+v"(tid_));
    const int tid = tid_, wid = __builtin_amdgcn_readfirstlane(tid >> 6), lane = tid & 63, wr = wid >> 2, wc = wid & 3, fr = lane & 15, fq = lane >> 4;
    const int nt = K / BK;
    unsigned voffA[2], voffB[2];
#pragma unroll
    for (int i = 0; i < 2; ++i) { int R, C; stage_rc(tid * 16 + i * 8192, R, C); const int Rb = Epi::PERM ? ((R & ~31) + perm32(R & 31)) : R;
        voffA[i] = (unsigned)(R * ldA + C) * 2u; voffB[i] = (unsigned)(Rb * ldB + C) * 2u; }
    const size_t kstep = (size_t)(BK * 2);
    const size_t hstepA = (size_t)HALF * ldA * 2, hstepB = (size_t)HALF * ldB * 2;
    const unsigned ldsw = (unsigned)wid * 1024u;
    const int aoff = lds_byte(wr * 64 + fr, fq * 8), boff = lds_byte(wc * 32 + fr, fq * 8);
#define PG8_SA(b, h) (((b) * 2 + (h)) * HTB)
#define PG8_SB(b, h) ((4 + (b) * 2 + (h)) * HTB)
#define PG8_STAGE(bufoff, gbase, voff) do { _Pragma("unroll") for (int _i = 0; _i < 2; ++_i) \
        __builtin_amdgcn_global_load_lds((const unsigned*)((const char*)(gbase) + (voff)[_i]), (LAS unsigned*)(lds + (bufoff) + ldsw + _i * 8192), 16, 0, 0); } while (0)
#define PG8_LDA(dst, b, h) do { _Pragma("unroll") for (int m = 0; m < 4; ++m) _Pragma("unroll") for (int k = 0; k < 2; ++k) dst[m][k] = *(const LAS bf16x8*)(lds + PG8_SA(b, h) + aoff + m * 2048 + k * 1024); } while (0)
#define PG8_LDB(dst, b, h) do { _Pragma("unroll") for (int n = 0; n < 2; ++n) _Pragma("unroll") for (int k = 0; k < 2; ++k) dst[n][k] = *(const LAS bf16x8*)(lds + PG8_SB(b, h) + boff + n * 2048 + k * 1024); } while (0)
#define PG8_MMA(ai, bj, At, Bt) do { __builtin_amdgcn_s_setprio(1); _Pragma("unroll") for (int m = 0; m < 4; ++m) _Pragma("unroll") for (int n = 0; n < 2; ++n) _Pragma("unroll") for (int k = 0; k < 2; ++k) \
        acc[ai][bj][m][n] = __builtin_amdgcn_mfma_f32_16x16x32_bf16(Bt[n][k], At[m][k], acc[ai][bj][m][n], 0, 0, 0); __builtin_amdgcn_s_setprio(0); } while (0)
#define PG8_WAIT_V(n) asm volatile("s_waitcnt vmcnt(" #n ")" ::: "memory")
#define PG8_WAIT_L(n) asm volatile("s_waitcnt lgkmcnt(" #n ")" ::: "memory")
#define PG8_BAR __builtin_amdgcn_s_barrier()
#define PG8_SCHED __builtin_amdgcn_sched_barrier(0)
    Unit cur, nxt; int ui = 0;
    if (!S.next(0, cur)) return;
    f32x4 acc[2][2][4][2];
#pragma unroll
    for (int a = 0; a < 2; ++a)
#pragma unroll
        for (int b = 0; b < 2; ++b)
#pragma unroll
            for (int m = 0; m < 4; ++m)
#pragma unroll
                for (int n = 0; n < 2; ++n) acc[a][b][m][n] = (f32x4){0.f, 0.f, 0.f, 0.f};
    bf16x8 At[4][2], B0[2][2], B1[2][2];
    const char* cA = cur.a; const char* cB = cur.b;
    PG8_STAGE(PG8_SB(0, 0), cB, voffB); PG8_STAGE(PG8_SB(0, 1), cB + hstepB, voffB); PG8_STAGE(PG8_SA(0, 0), cA, voffA); PG8_STAGE(PG8_SA(0, 1), cA + hstepA, voffA);
    if (wr == 1) PG8_BAR;
    PG8_WAIT_V(2); PG8_BAR;
    PG8_STAGE(PG8_SB(1, 0), cB + kstep, voffB); PG8_STAGE(PG8_SA(1, 0), cA + kstep, voffA); PG8_STAGE(PG8_SB(1, 1), cB + hstepB + kstep, voffB);
    PG8_WAIT_V(6); PG8_BAR;
    for (;;) {
        const bool has_next = S.next(ui + 1, nxt);
        const char* nA = has_next ? nxt.a : cA; const char* nB = has_next ? nxt.b : cB;
        for (int t = 0; t < nt; t += 2) {
            const bool last = (t == nt - 2);
            const char* a1 = cA + (size_t)(t + 1) * kstep;
            const char* a2 = last ? nA : cA + (size_t)(t + 2) * kstep; const char* b2 = last ? nB : cB + (size_t)(t + 2) * kstep;
            const char* a3 = a2 + kstep; const char* b3 = b2 + kstep;
            PG8_LDB(B0, 0, 0); PG8_LDB(B1, 0, 1); PG8_SCHED; PG8_LDA(At, 0, 0); PG8_STAGE(PG8_SA(1, 1), a1 + hstepA, voffA);
            PG8_WAIT_V(8); PG8_WAIT_L(0); PG8_BAR; PG8_MMA(0, 0, At, B0); PG8_MMA(0, 1, At, B1); PG8_BAR; PG8_SCHED;
            PG8_LDA(At, 0, 1); PG8_STAGE(PG8_SB(0, 0), b2, voffB); PG8_STAGE(PG8_SB(0, 1), b2 + hstepB, voffB); PG8_STAGE(PG8_SA(0, 0), a2, voffA);
            PG8_WAIT_V(8); PG8_WAIT_L(0); PG8_BAR; PG8_MMA(1, 0, At, B0); PG8_MMA(1, 1, At, B1); PG8_BAR; PG8_SCHED;
            PG8_LDB(B0, 1, 0); PG8_LDB(B1, 1, 1); PG8_SCHED; PG8_LDA(At, 1, 0); PG8_STAGE(PG8_SA(0, 1), a2 + hstepA, voffA);
            PG8_WAIT_V(8); PG8_WAIT_L(0); PG8_BAR; PG8_MMA(0, 0, At, B0); PG8_MMA(0, 1, At, B1); PG8_BAR; PG8_SCHED;
            PG8_LDA(At, 1, 1); PG8_STAGE(PG8_SB(1, 0), b3, voffB); PG8_STAGE(PG8_SB(1, 1), b3 + hstepB, voffB); PG8_STAGE(PG8_SA(1, 0), a3, voffA);
            PG8_WAIT_V(8); PG8_WAIT_L(0); PG8_BAR; PG8_MMA(1, 0, At, B0); PG8_MMA(1, 1, At, B1); PG8_BAR; PG8_SCHED;
        }
        if (wr == 0) PG8_BAR;
        E(acc, cur, wr, wc, fr, fq);
        if (!has_next) break;
#pragma unroll
        for (int a = 0; a < 2; ++a)
#pragma unroll
            for (int b = 0; b < 2; ++b)
#pragma unroll
                for (int m = 0; m < 4; ++m)
#pragma unroll
                    for (int n = 0; n < 2; ++n) acc[a][b][m][n] = (f32x4){0.f, 0.f, 0.f, 0.f};
        cur = nxt; cA = nA; cB = nB; ++ui;
        if (wr == 1) PG8_BAR;
    }
    PG8_WAIT_V(0);
    PG8_BAR;
#undef PG8_SA
#undef PG8_SB
#undef PG8_STAGE
#undef PG8_LDA
#undef PG8_LDB
#undef PG8_MMA
#undef PG8_WAIT_V
#undef PG8_WAIT_L
#undef PG8_BAR
#undef PG8_SCHED
}

typedef const f32x4 (&AccRef)[2][2][4][2];
template <int ACT  > struct EpiGated {
    static constexpr bool PERM = true;
    bf16_t* O; int ldc;
    __device__ __forceinline__ void operator()(AccRef acc, const Unit& u, int wr, int wc, int fr, int fq) const {
        const int row0 = u.pm * BM + wr * 64 + fr, hcol0 = u.pn * 128 + wc * 16 + 4 * fq;
#pragma unroll
        for (int ai = 0; ai < 2; ++ai)
#pragma unroll
            for (int m = 0; m < 4; ++m) { int rr_ = row0 + ai * HALF + m * 16; asm volatile("" : "+v"(rr_) :: "memory"); bf16_t* rowp = O + (size_t)rr_ * ldc + hcol0;
#pragma unroll
                for (int bj = 0; bj < 2; ++bj) { const f32x4 a = acc[ai][bj][m][0], b = acc[ai][bj][m][1]; float v[4];
#pragma unroll
                    for (int j = 0; j < 4; ++j) v[j] = (ACT == 0) ? a[j] * sigmoidf_(a[j]) * b[j] : a[j] * sigmoidf_(b[j]);
                    u32x2 w; w.x = cvt_pk_bf16(v[0], v[1]); w.y = cvt_pk_bf16(v[2], v[3]); *(u32x2*)(rowp + bj * 64) = w; } }
    }
};
template <int NB, int HALFC> struct EpiResidT {
    static constexpr bool PERM = false; static constexpr float coef = HALFC ? 0.5f : 1.0f;
    float* X; const float* gate; const float* Xs;
    __device__ __forceinline__ void operator()(AccRef acc, const Unit& u, int wr, int wc, int fr, int fq) const {
        const int cond = (u.pm < 32) ? 0 : 1 + ((u.pm - 32) >> 3);
        const float* gp = gate + (size_t)cond * 9216;
        const int col0 = u.pn * BM + wc * 32 + 4 * fq;
        f32x4 gv[2][2];
#pragma unroll
        for (int bj = 0; bj < 2; ++bj)
#pragma unroll
            for (int n = 0; n < 2; ++n) gv[bj][n] = *(const f32x4*)(gp + col0 + bj * HALF + n * 16) * coef;
        constexpr int RPB = 8 / NB;
#pragma unroll
        for (int b = 0; b < NB; ++b) {
            int r0 = u.pm * BM + wr * 64 + fr; asm volatile("" : "+v"(r0) :: "memory");
            f32x4 xv[RPB][2][2];
#pragma unroll
            for (int q = 0; q < RPB; ++q) { const int am = b * RPB + q, ai = am >> 2, m = am & 3; const float* rowp = Xs + (size_t)(r0 + ai * HALF + m * 16) * DM + col0;
#pragma unroll
                for (int bj = 0; bj < 2; ++bj)
#pragma unroll
                    for (int n = 0; n < 2; ++n) xv[q][bj][n] = *(const f32x4*)(rowp + bj * HALF + n * 16); }
#pragma unroll
            for (int q = 0; q < RPB; ++q) { const int am = b * RPB + q, ai = am >> 2, m = am & 3; float* rowp = X + (size_t)(r0 + ai * HALF + m * 16) * DM + col0;
#pragma unroll
                for (int bj = 0; bj < 2; ++bj)
#pragma unroll
                    for (int n = 0; n < 2; ++n) *(f32x4*)(rowp + bj * HALF + n * 16) = xv[q][bj][n] + gv[bj][n] * acc[ai][bj][m][n]; }
        }
    }
};
__device__ __forceinline__ u32x4 pack8(const f32x4 v0, const f32x4 v1) { u32x4 w; w.x = cvt_pk_bf16(v0[0], v0[1]); w.y = cvt_pk_bf16(v0[2], v0[3]); w.z = cvt_pk_bf16(v1[0], v1[1]); w.w = cvt_pk_bf16(v1[2], v1[3]); return w; }
struct EpiWin {
    static constexpr bool PERM = true;
    bf16_t *MIX, *KVRAW, *UT, *AC;
    __device__ __forceinline__ void operator()(AccRef acc, const Unit& u, int wr, int wc, int fr, int fq) const {
#pragma unroll
        for (int ai = 0; ai < 2; ++ai)
#pragma unroll
            for (int m = 0; m < 4; ++m) { int row = u.pm * BM + ai * HALF + wr * 64 + m * 16 + fr; asm volatile("" : "+v"(row) :: "memory");
#pragma unroll
                for (int bj = 0; bj < 2; ++bj) { const int c0 = u.pn * BM + bj * HALF + wc * 32 + 8 * fq; const f32x4 v0 = acc[ai][bj][m][0], v1 = acc[ai][bj][m][1];
                    if (u.pn <= 1) { *(u32x4*)(MIX + (size_t)row * MIXW + c0) = pack8(v0, v1); }
                    else if (u.pn == 2) { *(u32x4*)(KVRAW + (size_t)row * 256 + (c0 - 512)) = pack8(v0, v1); }
                    else if (u.pn == 3) { const int ch0 = c0 - 768; bf16_t* p;
                        if (row < MC) p = UT + ((size_t)((row >> 8) * 256 + ch0)) * 256 + (row & 255);
                        else { const int rr = row - MC, t = rr & 2047; p = UT + (size_t)MC * 256 + ((size_t)((((rr >> 11) * 2 + (ch0 >> 7)) * 2 + (t & 1)) * 128 + (ch0 & 127))) * 1024 + (t >> 1); }
                        const size_t st = (row < MC) ? 256 : 1024; const u32x4 w = pack8(v0, v1);
                        p[0] = (bf16_t)(w.x & 0xffff); p[st] = (bf16_t)(w.x >> 16); p[2 * st] = (bf16_t)(w.y & 0xffff); p[3 * st] = (bf16_t)(w.y >> 16);
                        p[4 * st] = (bf16_t)(w.z & 0xffff); p[5 * st] = (bf16_t)(w.z >> 16); p[6 * st] = (bf16_t)(w.w & 0xffff); p[7 * st] = (bf16_t)(w.w >> 16); }
                    else { const int cc = c0 - 1024, g = cc >> 4, h0 = cc & 15, chunk = row >> 5, tp = row & 31;
                        *(u32x4*)(AC + ((size_t)g * 768 + chunk) * 768 + tp * 16 + h0) = pack8(v0, v1); } } }
    }
};
template <int LAT> struct EpiDFT {
    static constexpr bool PERM = true;
    bf16_t* MIX;
    __device__ __forceinline__ void operator()(AccRef acc, const Unit& u, int wr, int wc, int fr, int fq) const {
#pragma unroll
        for (int ai = 0; ai < 2; ++ai)
#pragma unroll
            for (int m = 0; m < 4; ++m) { int R = u.pm * BM + ai * HALF + wr * 64 + m * 16 + fr; asm volatile("" : "+v"(R) :: "memory");
                const int cs = LAT ? (R >> 11) : (R >> 8), k = LAT ? (R & 2047) : (R & 255), tok = LAT ? (MC + u.z * 2048 + k) : (u.z * 256 + k);
#pragma unroll
                for (int bj = 0; bj < 2; ++bj) { const int ch0 = bj * HALF + wc * 32 + 8 * fq;
                    *(u32x4*)(MIX + (size_t)tok * MIXW + 512 + cs * 256 + ch0) = pack8(acc[ai][bj][m][0], acc[ai][bj][m][1]); } }
    }
};
struct EpiFold {
    static constexpr bool PERM = false;
    bf16_t* WO;
    __device__ __forceinline__ void operator()(AccRef acc, const Unit& u, int wr, int wc, int fr, int fq) const {
#pragma unroll
        for (int ai = 0; ai < 2; ++ai)
#pragma unroll
            for (int m = 0; m < 4; ++m) { int R = u.pm * BM + ai * HALF + wr * 64 + m * 16 + fr; asm volatile("" : "+v"(R) :: "memory");
#pragma unroll
                for (int bj = 0; bj < 2; ++bj)
#pragma unroll
                    for (int n = 0; n < 2; ++n) { const int c = u.pn * BM + bj * HALF + wc * 32 + n * 16 + 4 * fq; const f32x4 v = acc[ai][bj][m][n];
                        bf16_t* p = WO + ((size_t)u.z * 1024 + c) * 1280 + 512 + R; const unsigned w0 = cvt_pk_bf16(v[0], v[1]), w1 = cvt_pk_bf16(v[2], v[3]);
                        p[0] = (bf16_t)(w0 & 0xffff); p[1280] = (bf16_t)(w0 >> 16); p[2560] = (bf16_t)(w1 & 0xffff); p[3840] = (bf16_t)(w1 >> 16); } }
    }
};
struct EpiDFT2 {
    static constexpr bool PERM = true;
    bf16_t* MIX; const f32x2* TW;
    __device__ __forceinline__ void operator()(AccRef acc, const Unit& u, int wr, int wc, int fr, int fq) const {
        const int ch0 = u.pn * 128 + wc * 32 + 8 * fq;
#pragma unroll
        for (int m = 0; m < 4; ++m) { int kp = u.pm * 128 + wr * 64 + m * 16 + fr; asm volatile("" : "+v"(kp) :: "memory");
            const f32x2 tw = TW[kp]; const float c = tw.x, s = tw.y;
            bf16_t* p1 = MIX + (size_t)(MC + u.z * 2048 + kp) * MIXW + 512 + ch0; bf16_t* p2 = p1 + (size_t)1024 * MIXW;
            f32x4 C1[2], S1[2], C2[2], S2[2];
#pragma unroll
            for (int n = 0; n < 2; ++n) { const f32x4 Ec = acc[0][0][m][n], Es = acc[1][0][m][n], Oc = acc[0][1][m][n], Os = acc[1][1][m][n];
                const f32x4 tc = Oc * c - Os * s, ts = Os * c + Oc * s; C1[n] = Ec + tc; S1[n] = Es + ts; C2[n] = Ec - tc; S2[n] = Es - ts; }
            *(u32x4*)p1 = pack8(C1[0], C1[1]); *(u32x4*)(p1 + 256) = pack8(S1[0], S1[1]); *(u32x4*)p2 = pack8(C2[0], C2[1]); *(u32x4*)(p2 + 256) = pack8(S2[0], S2[1]); }
    }
};
struct EpiSsmA {
    static constexpr bool PERM = false;
    float* SEND;
    __device__ __forceinline__ void operator()(AccRef acc, const Unit& u, int wr, int wc, int fr, int fq) const {
#pragma unroll
        for (int ai = 0; ai < 2; ++ai)
#pragma unroll
            for (int m = 0; m < 4; ++m) { int R = u.pm * BM + ai * HALF + wr * 64 + m * 16 + fr; asm volatile("" : "+v"(R) :: "memory"); float* rowp = SEND + ((size_t)u.z * 768 + R) * 256 + wc * 32 + 4 * fq;
#pragma unroll
                for (int bj = 0; bj < 2; ++bj)
#pragma unroll
                    for (int n = 0; n < 2; ++n) *(f32x4*)(rowp + bj * HALF + n * 16) = acc[ai][bj][m][n]; }
    }
};
struct EpiSsmC {
    static constexpr bool PERM = true;
    bf16_t* Y;
    __device__ __forceinline__ void operator()(AccRef acc, const Unit& u, int wr, int wc, int fr, int fq) const {
#pragma unroll
        for (int ai = 0; ai < 2; ++ai)
#pragma unroll
            for (int m = 0; m < 4; ++m) { int R = u.pm * BM + ai * HALF + wr * 64 + m * 16 + fr; asm volatile("" : "+v"(R) :: "memory");
#pragma unroll
                for (int bj = 0; bj < 2; ++bj) { const int c0 = u.pn * BM + bj * HALF + wc * 32 + 8 * fq, tp = c0 >> 4, h0 = c0 & 15;
                    f32x4 v0 = acc[ai][bj][m][0], v1 = acc[ai][bj][m][1];
#pragma unroll
                    for (int j = 0; j < 4; ++j) { v0[j] = gelu_tanh(v0[j]); v1[j] = gelu_tanh(v1[j]); }
                    *(u32x4*)(Y + (size_t)(R * 32 + tp) * 256 + u.z * 16 + h0) = pack8(v0, v1); } }
    }
};
}

using pg8::pack8;
struct Args { const float* in[N_IN]; float* out; unsigned char* ws; };
constexpr int PTR_OFF = 146944;
struct Ctx {
    float* out; unsigned char* ws;
    LAS unsigned char* lds;
    int wid0; int tid, lane, wid, G, bx, gw, NGW, gtid, NGT;
};
__device__ __forceinline__ const float* inp(const Ctx& C, int i) { return *(const float* const LAS*)(C.lds + PTR_OFF + i * 8); }
__device__ __forceinline__ unsigned char* opq(unsigned char* p) { asm volatile("" : "+s"(p)); return p; }
__device__ __forceinline__ float* opq(float* p) { asm volatile("" : "+s"(p)); return p; }
__device__ __forceinline__ void refresh(Ctx& C) {
    int w0 = C.wid0; asm volatile("" : "+s"(w0)); int ln; asm volatile("v_mbcnt_lo_u32_b32 %0, -1, 0\n\tv_mbcnt_hi_u32_b32 %0, -1, %0" : "=&v"(ln));
    int t = w0 * 64 + ln; int b = blockIdx.x; asm volatile("" : "+s"(b)); int g = gridDim.x; asm volatile("" : "+s"(g));
    C.tid = t; C.lane = ln; C.wid = w0; C.G = g; C.bx = b;
    C.gw = b * 8 + C.wid; C.NGW = g * 8; C.gtid = b * 512 + t; C.NGT = g * 512;
    C.ws = opq(C.ws); C.out = opq(C.out);
}
__device__ __forceinline__ float shx(float v, int k, int lane) { return __int_as_float(__builtin_amdgcn_ds_bpermute((lane ^ k) << 2, __float_as_int(v))); }
__device__ __forceinline__ float wave_sum(float v, int lane) {
#pragma unroll
    for (int o = 1; o < 64; o <<= 1) v += shx(v, o, lane);
    return v;
}

__device__ __forceinline__ void p0_mod(Ctx C) {
    refresh(C);
    LAS float* s = (LAS float*)C.lds;
    LAS float* red = (LAS float*)(C.lds + 9 * 1024 * 4);
    float* mod = (float*)(C.ws + WS_MOD);
    for (int i = C.tid; i < 9 * 1024; i += 512) { const int c = i >> 10, k = i & 1023; const float v = (c == 0) ? inp(C, I_CCTX)[k] : inp(C, I_C)[(c - 1) * 1024 + k]; s[i] = v * sigmoidf_(v); }
    __syncthreads();
    for (int it = C.bx; it < 576; it += C.G) {
        const int l = it / 288, n0 = (it % 288) * 32;
        const float* W = inp(C, I_WMOD) + (size_t)l * 1024 * 9216 + n0 + (C.lane & 31);
        float acc[9];
#pragma unroll
        for (int c = 0; c < 9; ++c) acc[c] = 0.f;
        const int k0 = C.wid * 128 + (C.lane >> 5);
#pragma unroll 16
        for (int kk = 0; kk < 64; ++kk) { const int k = k0 + 2 * kk; const float w = __builtin_nontemporal_load(W + (size_t)k * 9216);
#pragma unroll
            for (int c = 0; c < 9; ++c) acc[c] += s[c * 1024 + k] * w; }
#pragma unroll
        for (int c = 0; c < 9; ++c) red[(C.wid * 9 + c) * 64 + C.lane] = acc[c];
        __syncthreads();
        for (int i = C.tid; i < 9 * 32; i += 512) { const int c = i >> 5, n = i & 31; float v = 0.f;
#pragma unroll
            for (int w = 0; w < 8; ++w) v += red[(w * 9 + c) * 64 + n] + red[(w * 9 + c) * 64 + 32 + n];
            mod[((size_t)l * 9 + c) * 9216 + n0 + n] = v + inp(C, I_BMOD)[(size_t)l * 9216 + n0 + n]; }
        __syncthreads();
    }
}

struct TDesc { const float* src; bf16_t* dst; int N, ldt, n0, mode, which, nsub; };
__device__ __forceinline__ void t_make(TDesc& d, const float* W, int N, int ksrc0, bf16_t* WT, int ldt, int koff, int mode, int which, int nsub, int item, int nblk) {
    const int kb = item / nblk, nb = item % nblk, k0 = 64 * kb, n0 = 32 * nb;
    d.src = W + (size_t)(ksrc0 + k0) * N + n0; d.dst = WT + koff + k0; d.N = N; d.ldt = ldt; d.n0 = n0; d.mode = mode; d.which = which; d.nsub = nsub;
}
__device__ __forceinline__ void t_decode(const Ctx& C, int it, TDesc& d) {
    constexpr int PER_L = 8448 + 640 + 256 + 128 + 128 + 64;
    const int l = it / PER_L; int r = it % PER_L;
    if (r < 8448) { const int f = r / 4224, rr = r % 4224, which = rr / 1408, idx = rr % 1408; const size_t lf = (size_t)(l * 2 + f);
        if (which < 2) t_make(d, (which == 0 ? inp(C, I_W1) : inp(C, I_W3)) + lf * 1024 * 2816, 2816, 0, (bf16_t*)(C.ws + WS_W13T) + lf * 5632 * 1024, 1024, 0, 1, which, 0, idx, 88);
        else t_make(d, inp(C, I_W2) + lf * 2816 * 1024, 1024, 0, (bf16_t*)(C.ws + WS_W2T) + lf * 1024 * 2816, 2816, 0, 0, 0, 0, idx, 32);
        return; }
    r -= 8448;
    if (r < 640) { t_make(d, inp(C, I_WIN) + (size_t)l * 1024 * 1280, 1280, 0, (bf16_t*)(C.ws + WS_WINT) + (size_t)l * 1280 * 1024, 1024, 0, 0, 0, 0, r, 40); return; }
    r -= 640;
    if (r < 256) { t_make(d, inp(C, I_WOUT) + (size_t)l * 1024 * 1024, 1024, 0, (bf16_t*)(C.ws + WS_WOUTT) + (size_t)l * 1024 * 1280, 1280, 0, 0, 0, 0, r, 32); return; }
    r -= 256;
    if (r < 128) { t_make(d, inp(C, I_WOUT) + (size_t)l * 1024 * 1024, 1024, 768, (bf16_t*)(C.ws + WS_WOUTT) + (size_t)l * 1024 * 1280, 1280, 1024, 0, 0, 0, r, 32); return; }
    r -= 128;
    if (r < 128) { t_make(d, inp(C, I_WOUT) + (size_t)l * 1024 * 1024, 1024, 512, (bf16_t*)(C.ws + WS_WOFT) + (size_t)l * 1024 * 256, 256, 0, 0, 0, 0, r, 32); return; }
    r -= 128;
    { const int nb = r % 16; const int which = nb >> 3;
      t_make(d, inp(C, I_GLU) + (size_t)l * 256 * 512, 512, 0, (bf16_t*)(C.ws + WS_WGLUT) + (size_t)l * 512 * 256, 256, 0, 1, which, which * 256, r, 16); }
}
__device__ __forceinline__ void t_load(const TDesc& d, float (&v)[32], int lane) {
#pragma unroll
    for (int i = 0; i < 32; ++i) v[i] = __builtin_nontemporal_load(d.src + (size_t)(2 * i + (lane >> 5)) * d.N + (lane & 31));
}
__device__ __forceinline__ void t_finish(const TDesc& d, const float (&v)[32], LAS float* scr, int lane) {
#pragma unroll
    for (int i = 0; i < 32; ++i) scr[(2 * i + (lane >> 5)) * 33 + (lane & 31)] = v[i];
    asm volatile("s_waitcnt lgkmcnt(0)" ::: "memory");
    const int c = lane & 7;
#pragma unroll
    for (int j = 0; j < 4; ++j) { const int n = (lane >> 3) + 8 * j; const LAS float* sp = scr + (8 * c) * 33 + n;
        u32x4 o; o.x = cvt_pk_bf16(sp[0 * 33], sp[1 * 33]); o.y = cvt_pk_bf16(sp[2 * 33], sp[3 * 33]); o.z = cvt_pk_bf16(sp[4 * 33], sp[5 * 33]); o.w = cvt_pk_bf16(sp[6 * 33], sp[7 * 33]);
        int row = d.n0 + n; if (d.mode == 1) { const int h = row - d.nsub; row = (h >> 2) * 8 + d.which * 4 + (h & 3); }
        *(u32x4*)(d.dst + (size_t)row * d.ldt + 8 * c) = o; }
    asm volatile("s_waitcnt lgkmcnt(0)" ::: "memory");
}
__device__ __forceinline__ void p0_weights(Ctx C, int l_lo, int l_hi, int wg_lo) {
    refresh(C);
    if (C.bx < wg_lo) return;
    C.gw -= wg_lo * 8; C.NGW -= wg_lo * 8;
    LAS float* scr = (LAS float*)(C.lds + 65536 + C.wid * 8448);
    constexpr int PER_L = 8448 + 640 + 256 + 128 + 128 + 64;
    const int end = l_hi * PER_L;
    int it = l_lo * PER_L + C.gw;
    if (it >= end) return;
    TDesc da; float va[32];
    t_decode(C, it, da); t_load(da, va, C.lane);
    for (;;) {
        const int nx = it + C.NGW; const bool hn = nx < end;
        TDesc db = da; float vb[32];
        if (hn) { t_decode(C, nx, db); t_load(db, vb, C.lane); }
        t_finish(da, va, scr, C.lane);
        if (!hn) break;
        da = db; it = nx;
#pragma unroll
        for (int i = 0; i < 32; ++i) va[i] = vb[i];
    }
}

__device__ __forceinline__ void p0_tables(Ctx C) {
    refresh(C);
    { f32x2* P = (f32x2*)(C.ws + WS_PTAB);
      for (int i = C.gtid; i < 2 * 2 * 16 * 64 * 34; i += C.NGT) { const int e = i % 34, ch = i / 34;
        const double lre = (double)inp(C, I_LRE)[ch], lim = (double)inp(C, I_LIM)[ch], step = exp((double)inp(C, I_LS)[ch >> 6]);
        const double ee = (e <= 32) ? (double)e : 1.0;
        const double mag = exp(lre * step * ee); double ang = lim * step * ee; ang -= 6.283185307179586476925 * rint(ang / 6.283185307179586476925);
        double pr = mag * cos(ang), pi = mag * sin(ang);
        if (e == 33) { const double nr = pr - 1.0, ni = pi, den = lre * lre + lim * lim; pr = (nr * lre + ni * lim) / den; pi = (ni * lre - nr * lim) / den; }
        P[i] = (f32x2){(float)pr, (float)pi}; } }
    { bf16_t* D = (bf16_t*)(C.ws + WS_DFTL); const float sc = 0.00276213586f;
      for (int i = C.gtid; i < 2048 * 128; i += C.NGT) { const int row = i >> 7, t0 = (i & 127) * 8, cs = (row >> 7) & 1, k = (row >> 8) * 128 + (row & 127); float v[8];
#pragma unroll
        for (int j = 0; j < 8; ++j) { const int ph = (k * (t0 + j)) & 1023; const float x = (float)ph * (1.0f / 512.0f); v[j] = (cs ? sinpif(x) : cospif(x)) * sc; }
        u32x4 w; w.x = cvt_pk_bf16(v[0], v[1]); w.y = cvt_pk_bf16(v[2], v[3]); w.z = cvt_pk_bf16(v[4], v[5]); w.w = cvt_pk_bf16(v[6], v[7]);
        *(u32x4*)(D + (size_t)row * 1024 + t0) = w; }
      f32x2* T = (f32x2*)(C.ws + WS_TWID);
      for (int i = C.gtid; i < 1024; i += C.NGT) { const float x = (float)i * (1.0f / 1024.0f); T[i] = (f32x2){cospif(x), sinpif(x)}; } }
    { bf16_t* D = (bf16_t*)(C.ws + WS_DFTC); const float sc = 0.0078125f;
      for (int i = C.gtid; i < 512 * 32; i += C.NGT) { const int row = i >> 5, t0 = (i & 31) * 8, cs = row >> 8, k = row & 255; float v[8];
#pragma unroll
        for (int j = 0; j < 8; ++j) { const int ph = (k * (t0 + j)) & 255; const float x = (float)ph * (1.0f / 128.0f); v[j] = (cs ? sinpif(x) : cospif(x)) * sc; }
        u32x4 w; w.x = cvt_pk_bf16(v[0], v[1]); w.y = cvt_pk_bf16(v[2], v[3]); w.z = cvt_pk_bf16(v[4], v[5]); w.w = cvt_pk_bf16(v[6], v[7]);
        *(u32x4*)(D + (size_t)row * 256 + t0) = w; } }
    { LAS float* ctab = (LAS float*)(C.lds + 140000);
      if (C.tid < 64) ctab[C.tid] = cospif((float)C.tid * (1.0f / 32.0f));
      __syncthreads();
      bf16_t* TW = (bf16_t*)(C.ws + WS_TW);
      for (int i = C.gtid; i < 2 * 512 * 256; i += C.NGT) { const int j = i & 255, kk = (i >> 8) & 511, l = i >> 17, cs = kk >> 8, hd = (kk >> 6) & 3, d = kk & 63;
        const float* wf = inp(C, I_WF) + ((size_t)l * 256 + hd * 64) * 256 + j; float a = 0.f;
#pragma unroll 16
        for (int m = 0; m < 64; ++m) { const int ph = (d * m) & 63; const float t = cs ? -ctab[(ph + 48) & 63] : ctab[ph]; a += t * wf[(size_t)m * 256]; }
        TW[i] = (bf16_t)(cvt_pk_bf16(a, a) & 0xffff); } }
    { f32x2* R = (f32x2*)(C.ws + WS_ROPE);
      for (int i = C.gtid; i < 1024; i += C.NGT) { const int pos = i >> 4, fi = i & 15; const float invf = exp2f(-(float)fi * (13.287712379549449f / 16.0f)); const float ang = (float)pos * invf;
        R[i] = (f32x2){(float)cos((double)ang), (float)sin((double)ang)}; } }
    { bf16_t* Kc = (bf16_t*)(C.ws + WS_KC);
      for (int i = C.gtid; i < 2 * 8 * 256 * 16; i += C.NGT) { const int c8 = i & 15, t = (i >> 4) & 255, b = (i >> 12) & 7, l = i >> 15;
        const float* src = inp(C, I_CK) + (((size_t)(b * 2 + l) * 256 + t) * 128 + c8 * 8); const f32x4 a = *(const f32x4*)src, bb = *(const f32x4*)(src + 4);
        u32x4 w; w.x = cvt_pk_bf16(a[0], a[1]); w.y = cvt_pk_bf16(a[2], a[3]); w.z = cvt_pk_bf16(bb[0], bb[1]); w.w = cvt_pk_bf16(bb[2], bb[3]);
        *(u32x4*)(Kc + (((size_t)(l * 8 + b) * 256 + t) * 128 + c8 * 8)) = w; }
      bf16_t* Vt = (bf16_t*)(C.ws + WS_VTC);
      for (int i = C.gtid; i < 2 * 8 * 128 * 32; i += C.NGT) { const int t8 = i & 31, hd = (i >> 5) & 127, b = (i >> 12) & 7, l = i >> 15;
        const float* src = inp(C, I_CV) + (((size_t)(b * 2 + l) * 256 + t8 * 8) * 128 + hd); float v[8];
#pragma unroll
        for (int j = 0; j < 8; ++j) v[j] = src[(size_t)j * 128];
        u32x4 w; w.x = cvt_pk_bf16(v[0], v[1]); w.y = cvt_pk_bf16(v[2], v[3]); w.z = cvt_pk_bf16(v[4], v[5]); w.w = cvt_pk_bf16(v[6], v[7]);
        *(u32x4*)(Vt + (((size_t)(l * 8 + b) * 128 + hd) * 256 + t8 * 8)) = w; } }
}

__device__ __forceinline__ void p1_tables(Ctx C, int wg_lo) {
    refresh(C);
    if (C.bx < wg_lo) return;
    C.bx -= wg_lo; C.G -= wg_lo; C.gtid -= wg_lo * 512; C.NGT -= wg_lo * 512;
    const f32x2* P = (const f32x2*)(C.ws + WS_PTAB);
    { float* Kt = (float*)(C.ws + WS_KTAB);
      LAS f32x2* sCt = (LAS f32x2*)C.lds;
      LAS f32x2* sW = sCt + 1024;
      LAS float* sBr = (LAS float*)(sW + 2048);
      LAS float* sBi = sBr + 1024;
      for (int task = C.bx; task < 64; task += C.G) { const int r = task & 1, g = (task >> 1) & 15, l = task >> 5; const int chb = (l * 2 + r) * 16 + g;
        for (int i = C.tid; i < 1024; i += 512) { const int p = i >> 4, h = i & 15; sCt[i] = (f32x2){inp(C, I_CRE)[((size_t)chb * 16 + h) * 64 + p], inp(C, I_CIM)[((size_t)chb * 16 + h) * 64 + p]};
            sBr[i] = inp(C, I_BRE)[(size_t)chb * 1024 + i]; sBi[i] = inp(C, I_BIM)[(size_t)chb * 1024 + i]; }
        for (int i = C.tid; i < 2048; i += 512) { const int p = i >> 5, tau = i & 31; const f32x2 pw = P[((size_t)chb * 64 + p) * 34 + tau], cf = P[((size_t)chb * 64 + p) * 34 + 33];
            sW[i] = (f32x2){pw.x * cf.x - pw.y * cf.y, pw.x * cf.y + pw.y * cf.x}; }
        __syncthreads();
        const int tau = C.tid >> 4, h = C.tid & 15; float acc[16];
#pragma unroll
        for (int q = 0; q < 16; ++q) acc[q] = 0.f;
        for (int p = 0; p < 64; ++p) { const f32x2 ct = sCt[p * 16 + h], w = sW[p * 32 + tau]; const float zr = ct.x * w.x - ct.y * w.y, zi = ct.x * w.y + ct.y * w.x;
#pragma unroll
            for (int q4 = 0; q4 < 4; ++q4) { const f32x4 br = *(const LAS f32x4*)(sBr + p * 16 + q4 * 4), bi = *(const LAS f32x4*)(sBi + p * 16 + q4 * 4);
#pragma unroll
                for (int q = 0; q < 4; ++q) acc[q4 * 4 + q] += zr * br[q] - zi * bi[q]; } }
        float* dst = Kt + ((((size_t)(l * 16 + g) * 2 + r) * 32 + tau) * 16 + h) * 16;
#pragma unroll
        for (int q4 = 0; q4 < 4; ++q4) *(f32x4*)(dst + q4 * 4) = (f32x4){acc[q4 * 4], acc[q4 * 4 + 1], acc[q4 * 4 + 2], acc[q4 * 4 + 3]};
        __syncthreads(); } }
    { bf16_t* WA = (bf16_t*)(C.ws + WS_WAT);
      for (int i = C.gtid; i < 2 * 16 * 256 * 64; i += C.NGT) { const int k8 = i & 63, n = (i >> 6) & 255, g = (i >> 14) & 15, l = i >> 18;
        const int r = n >> 7, ri = (n >> 6) & 1, p = n & 63, j = k8 >> 1, h0 = (k8 & 1) * 8, e = r == 0 ? 31 - j : j;
        const int ch = ((l * 2 + r) * 16 + g) * 64 + p; const f32x2 pw = P[(size_t)ch * 34 + e], cf = P[(size_t)ch * 34 + 33];
        const float wr_ = pw.x * cf.x - pw.y * cf.y, wi_ = pw.x * cf.y + pw.y * cf.x; float v[8];
#pragma unroll
        for (int q = 0; q < 8; ++q) { const float br = inp(C, I_BRE)[(size_t)ch * 16 + h0 + q], bi = inp(C, I_BIM)[(size_t)ch * 16 + h0 + q]; v[q] = ri == 0 ? (wr_ * br - wi_ * bi) : (wr_ * bi + wi_ * br); }
        u32x4 w; w.x = cvt_pk_bf16(v[0], v[1]); w.y = cvt_pk_bf16(v[2], v[3]); w.z = cvt_pk_bf16(v[4], v[5]); w.w = cvt_pk_bf16(v[6], v[7]);
        *(u32x4*)(WA + (((size_t)(l * 16 + g) * 256 + n) * 512 + k8 * 8)) = w; } }
}
__device__ __forceinline__ void p2_tables(Ctx C, int wg_lo) {
    refresh(C);
    if (C.bx < wg_lo) return;
    C.gtid -= wg_lo * 512; C.NGT -= wg_lo * 512;
    const f32x2* P = (const f32x2*)(C.ws + WS_PTAB); const float* Kt = (const float*)(C.ws + WS_KTAB); bf16_t* Mt = (bf16_t*)(C.ws + WS_MTT);
    for (int i = C.gtid; i < 2 * 16 * 512 * 96; i += C.NGT) { const int k8 = i % 96, rest = i / 96, n = rest & 511, g = (rest >> 9) & 15, l = rest >> 13;
        const int tp = n >> 4, h = n & 15; float v[8];
        if (k8 < 64) { const int j = k8 >> 1, hp0 = (k8 & 1) * 8;
#pragma unroll
            for (int q = 0; q < 8; ++q) v[q] = 0.f;
            if (j <= tp) { const float* kf = Kt + ((((size_t)(l * 16 + g) * 2 + 0) * 32 + (tp - j)) * 16 + h) * 16 + hp0;
#pragma unroll
                for (int q = 0; q < 8; ++q) v[q] += kf[q]; }
            if (j >= tp) { const float* kb = Kt + ((((size_t)(l * 16 + g) * 2 + 1) * 32 + (j - tp)) * 16 + h) * 16 + hp0;
#pragma unroll
                for (int q = 0; q < 8; ++q) v[q] += kb[q]; }
            if (j == tp && h >= hp0 && h < hp0 + 8) { const float dv = inp(C, I_SD)[(size_t)(l * 16 + g) * 16 + h];
#pragma unroll
                for (int q = 0; q < 8; ++q) if (hp0 + q == h) v[q] += dv; }
        } else { const int kk = (k8 - 64) * 8, r = kk >> 7, ri = (kk >> 6) & 1, p0 = kk & 63, e = r == 0 ? tp + 1 : 32 - tp;
            const int chb = ((l * 2 + r) * 16 + g);
#pragma unroll
            for (int q = 0; q < 8; ++q) { const int p = p0 + q; const f32x2 pw = P[((size_t)chb * 64 + p) * 34 + e];
                const float cr = inp(C, I_CRE)[((size_t)chb * 16 + h) * 64 + p], ci = inp(C, I_CIM)[((size_t)chb * 16 + h) * 64 + p];
                v[q] = ri == 0 ? (cr * pw.x - ci * pw.y) : -(cr * pw.y + ci * pw.x); } }
        u32x4 w; w.x = cvt_pk_bf16(v[0], v[1]); w.y = cvt_pk_bf16(v[2], v[3]); w.z = cvt_pk_bf16(v[4], v[5]); w.w = cvt_pk_bf16(v[6], v[7]);
        *(u32x4*)(Mt + (((size_t)(l * 16 + g) * 512 + n) * 768 + k8 * 8)) = w; }
}

__device__ __forceinline__ void norm_phase(Ctx C, int l, int idx, int first) {
    refresh(C);
    const float* mod = (const float*)(C.ws + WS_MOD) + (size_t)l * 9 * 9216; bf16_t* XN = (bf16_t*)(C.ws + WS_XN);
    const float* gptr = inp(C, I_NG) + ((size_t)l * 3 + idx) * 1024;
    constexpr int NR = 4;
    for (int m0 = C.gw * NR; m0 < MT; m0 += C.NGW * NR) {
        f32x4 v[NR][4];
#pragma unroll
        for (int r = 0; r < NR; ++r) { const int m = m0 + r;
            const float* xr = first ? (m < MC ? inp(C, I_XP) + (size_t)m * DM : inp(C, I_XS) + (size_t)(m - MC) * DM) : C.out + (size_t)m * DM;
#pragma unroll
            for (int j = 0; j < 4; ++j) v[r][j] = ((const f32x4*)xr)[C.lane + 64 * j]; }
        const float* sh = mod + (size_t)cond_of_row(m0) * 9216 + (3 * idx) * 1024; const float* sc = sh + 1024;
        f32x4 gg[4], s1[4], s0[4];
#pragma unroll
        for (int j = 0; j < 4; ++j) { gg[j] = ((const f32x4*)gptr)[C.lane + 64 * j]; s1[j] = ((const f32x4*)sc)[C.lane + 64 * j] + 1.0f; s0[j] = ((const f32x4*)sh)[C.lane + 64 * j]; gg[j] = gg[j] * s1[j]; }
#pragma unroll
        for (int r = 0; r < NR; ++r) { const int m = m0 + r; float ss = 0.f;
#pragma unroll
            for (int j = 0; j < 4; ++j) ss += (v[r][j][0] * v[r][j][0] + v[r][j][1] * v[r][j][1]) + (v[r][j][2] * v[r][j][2] + v[r][j][3] * v[r][j][3]);
            const float rstd = 1.0f / sqrtf(wave_sum(ss, C.lane) * (1.0f / DM) + 1e-6f);
            u32x2* o = (u32x2*)(XN + (size_t)m * DM);
#pragma unroll
            for (int j = 0; j < 4; ++j) { const f32x4 y = v[r][j] * rstd * gg[j] + s0[j]; u32x2 w; w.x = cvt_pk_bf16(y[0], y[1]); w.y = cvt_pk_bf16(y[2], y[3]); o[C.lane + 64 * j] = w; } }
    }
}

__device__ __forceinline__ void unpack8(const u32x4 w, float* v) { v[0] = bflo(w.x); v[1] = bfhi(w.x); v[2] = bflo(w.y); v[3] = bfhi(w.y); v[4] = bflo(w.z); v[5] = bfhi(w.z); v[6] = bflo(w.w); v[7] = bfhi(w.w); }
__device__ __forceinline__ void normrope8(float* v, const float* g8, int c, bool lat, int prow, int pcol, int lane, const LAS f32x2* rt) {
    float ss = 0.f;
#pragma unroll
    for (int j = 0; j < 8; ++j) ss += v[j] * v[j];
    ss += shx(ss, 1, lane); ss += shx(ss, 2, lane); ss += shx(ss, 4, lane);
    const float rs = 1.0f / sqrtf(ss * (1.0f / 64.0f) + 1e-6f);
#pragma unroll
    for (int j = 0; j < 8; ++j) v[j] = v[j] * rs * g8[j];
    float pv[8];
#pragma unroll
    for (int j = 0; j < 8; ++j) pv[j] = shx(v[j], 2, lane);
    if (lat) { const int pos = (c < 4) ? prow : pcol;
#pragma unroll
        for (int j = 0; j < 8; ++j) { const f32x2 t = rt[pos * 16 + (c & 1) * 8 + j]; const float cs = t.x, sn = t.y;
            v[j] = ((c & 2) == 0) ? (v[j] * cs - pv[j] * sn) : (pv[j] * sn + v[j] * cs); } }
}
__device__ __forceinline__ void qkv_prep(Ctx C, int l, int wg_lo) {
    refresh(C);
    if (C.bx < wg_lo) return;
    C.gw -= wg_lo * 8; C.NGW -= wg_lo * 8;
    bf16_t* MIX = (bf16_t*)(C.ws + WS_MIX); const bf16_t* KVRAW = (const bf16_t*)(C.ws + WS_KVRAW); bf16_t* KN = (bf16_t*)(C.ws + WS_KN); bf16_t* VT = (bf16_t*)(C.ws + WS_VT);
    LAS f32x2* rt = (LAS f32x2*)C.lds;
    for (int i = C.tid; i < 1024; i += 512) rt[i] = ((const f32x2*)(C.ws + WS_ROPE))[i];
    __syncthreads();
    const int c = C.lane & 7;
    float qg[8], kg[8];
#pragma unroll
    for (int j = 0; j < 8; ++j) { qg[j] = inp(C, I_QG)[l * 64 + c * 8 + j]; kg[j] = inp(C, I_KG)[l * 64 + c * 8 + j]; }
    for (int m0 = C.gw * 4; m0 < MT; m0 += C.NGW * 4) {
      u32x4 qraw[4], kvraw[4];
#pragma unroll
      for (int r = 0; r < 4; ++r) { qraw[r] = *(const u32x4*)(MIX + (size_t)(m0 + r) * MIXW + C.lane * 8); kvraw[r] = *(const u32x4*)(KVRAW + (size_t)(m0 + r) * 256 + (C.lane & 31) * 8); }
#pragma unroll
      for (int r = 0; r < 4; ++r) { const int m = m0 + r;
        const bool lat = m >= MC; const int t = lat ? ((m - MC) & 2047) : (m & 255); const int prow = t >> 6, pcol = t & 63;
        { bf16_t* qp = MIX + (size_t)m * MIXW + C.lane * 8; float v[8]; unpack8(qraw[r], v);
          normrope8(v, qg, c, lat, prow, pcol, C.lane, rt);
          u32x4 w; w.x = cvt_pk_bf16(v[0], v[1]); w.y = cvt_pk_bf16(v[2], v[3]); w.z = cvt_pk_bf16(v[4], v[5]); w.w = cvt_pk_bf16(v[6], v[7]); *(u32x4*)qp = w; }
        { float v[8]; unpack8(kvraw[r], v);
          float raw[8];
#pragma unroll
          for (int j = 0; j < 8; ++j) raw[j] = v[j];
          float ss = 0.f;
#pragma unroll
          for (int j = 0; j < 8; ++j) ss += v[j] * v[j];
          ss += shx(ss, 1, C.lane); ss += shx(ss, 2, C.lane); ss += shx(ss, 4, C.lane);
          const float rs = 1.0f / sqrtf(ss * (1.0f / 64.0f) + 1e-6f);
          float kn[8];
#pragma unroll
          for (int j = 0; j < 8; ++j) kn[j] = v[j] * rs * kg[j];
          float pv[8];
#pragma unroll
          for (int j = 0; j < 8; ++j) pv[j] = shx(kn[j], 2, C.lane);
          if (!lat) { const int b = m >> 8; float* dst = C.out + (C.lane < 16 ? O_CK : O_CV) + (((size_t)(b * 2 + l) * 256 + t) * 128 + (C.lane & 15) * 8);
              if (C.lane < 16) { *(f32x4*)dst = (f32x4){kn[0], kn[1], kn[2], kn[3]}; *(f32x4*)(dst + 4) = (f32x4){kn[4], kn[5], kn[6], kn[7]}; }
              else if (C.lane < 32) { *(f32x4*)dst = (f32x4){raw[0], raw[1], raw[2], raw[3]}; *(f32x4*)(dst + 4) = (f32x4){raw[4], raw[5], raw[6], raw[7]}; } }
          else { const int pos = (c < 4) ? prow : pcol;
#pragma unroll
              for (int j = 0; j < 8; ++j) { const f32x2 t = rt[pos * 16 + (c & 1) * 8 + j]; const float cs = t.x, sn = t.y;
                  kn[j] = ((c & 2) == 0) ? (kn[j] * cs - pv[j] * sn) : (pv[j] * sn + kn[j] * cs); } }
          if (C.lane < 16) { u32x4 w; w.x = cvt_pk_bf16(kn[0], kn[1]); w.y = cvt_pk_bf16(kn[2], kn[3]); w.z = cvt_pk_bf16(kn[4], kn[5]); w.w = cvt_pk_bf16(kn[6], kn[7]);
              *(u32x4*)(KN + (size_t)m * 128 + C.lane * 8) = w; } }
      }
    }
    for (int task = C.NGW - 1 - C.gw; task < MT / 64; task += C.NGW) { const int r0 = task * 64, m = r0 + C.lane; const bool lat = r0 >= MC;
        const int b = lat ? ((r0 - MC) >> 11) : (r0 >> 8), t = lat ? ((m - MC) & 2047) : (m & 255); const size_t L = lat ? 2048 : 256;
        bf16_t* base = VT + (lat ? (size_t)MC * 128 : 0) + (size_t)b * 128 * L + t;
#pragma unroll 4
        for (int ch = 0; ch < 16; ++ch) { const u32x4 w = *(const u32x4*)(KVRAW + (size_t)m * 256 + 128 + ch * 8); bf16_t* p = base + (size_t)(ch * 8) * L;
            p[0] = (bf16_t)(w.x & 0xffff); p[L] = (bf16_t)(w.x >> 16); p[2 * L] = (bf16_t)(w.y & 0xffff); p[3 * L] = (bf16_t)(w.y >> 16);
            p[4 * L] = (bf16_t)(w.z & 0xffff); p[5 * L] = (bf16_t)(w.z >> 16); p[6 * L] = (bf16_t)(w.w & 0xffff); p[7 * L] = (bf16_t)(w.w >> 16); } }
    __syncthreads();
}

__device__ __forceinline__ void carry_phase(Ctx C, int l) {
    refresh(C);
    const f32x2* P = (const f32x2*)(C.ws + WS_PTAB); const float* SEND = (const float*)(C.ws + WS_SEND); bf16_t* AC = (bf16_t*)(C.ws + WS_AC);
    for (int task = C.gw; task < 256 + 1024; task += C.NGW) {
        const bool lat = task < 256; const int id = (lat ? task : task - 256) * 64 + C.lane;
        const int p = id & 63, r = (id >> 6) & 1, g = (id >> 7) & 15, b = id >> 11;
        const int nc = lat ? 64 : 8, chunk0 = lat ? 256 + b * 64 : b * 8;
        const f32x2 lt = P[((size_t)((l * 2 + r) * 16 + g) * 64 + p) * 34 + 32];
        float sr = 0.f, si = 0.f;
        if (lat) { const size_t hi = ((size_t)((b * 2 + l) * 2 + r) * 16 + g) * 64 + p; sr = inp(C, I_SRE)[hi]; si = inp(C, I_SIM)[hi]; }
        const float* se = SEND + ((size_t)g * 768 + chunk0) * 256 + r * 128 + p; bf16_t* ac = AC + ((size_t)g * 768 + chunk0) * 768 + 512 + r * 128 + p;
#pragma unroll 8
        for (int cc = 0; cc < nc; ++cc) { const int ci = r == 0 ? cc : nc - 1 - cc;
            const float er = se[(size_t)ci * 256], ei = se[(size_t)ci * 256 + 64];
            ac[(size_t)ci * 768] = (bf16_t)(cvt_pk_bf16(sr, sr) & 0xffff); ac[(size_t)ci * 768 + 64] = (bf16_t)(cvt_pk_bf16(si, si) & 0xffff);
            const float nr = lt.x * sr - lt.y * si + er, ni = lt.x * si + lt.y * sr + ei; sr = nr; si = ni; }
        if (!lat) { const size_t oi = ((size_t)((b * 2 + l) * 2 + r) * 16 + g) * 64 + p; C.out[O_SRE + oi] = sr; C.out[O_SIM + oi] = si; }
    }
}

__device__ __forceinline__ void attn_phase(Ctx C, int l, int dummy_out = 0) {
    refresh(C);
    bf16_t* MIX = (bf16_t*)(C.ws + WS_MIX); const bf16_t* KN = (const bf16_t*)(C.ws + WS_KN); const bf16_t* VT = (const bf16_t*)(C.ws + WS_VT);
    const bf16_t* KC = (const bf16_t*)(C.ws + WS_KC) + (size_t)l * 8 * 256 * 128; const bf16_t* VTC = (const bf16_t*)(C.ws + WS_VTC) + (size_t)l * 8 * 128 * 256;
    LAS unsigned char* Ks = C.lds; LAS unsigned char* Vs = C.lds + 64 * 144;
    const int lane = C.lane, wid = C.wid, l15 = lane & 15, q4 = lane >> 4, gq = wid >> 1, half = wid & 1;
    const int sr_ = C.tid >> 3, sc_ = C.tid & 7;
    const float SC = 0.125f * 1.4426950408889634f;
    for (int u0 = C.bx; u0 < 768; u0 += C.G) {
        int u = u0;
        if (C.G == 256) { const int x = u0 & 7, s = (u0 >> 3) & 31, rnd = u0 >> 8;
            if (rnd < 2) u = ((rnd * 8 + x) << 5) + s;
            else u = 512 + ((((s >> 2) * 8 + x) << 2) | (s & 3)); }
        const bool lat = u < 512; int b, hk, qb; if (lat) { b = u >> 6; hk = (u >> 5) & 1; qb = u & 31; } else { const int v = u - 512; b = v >> 3; hk = (v >> 2) & 1; qb = v & 3; }
        const int rowbase = lat ? MC + b * 2048 : b * 256;
        const int lt_lo = lat ? (qb - 2 < 0 ? 0 : qb - 2) : 0, lt_hi = lat ? (qb + 2 > 31 ? 31 : qb + 2) : 3;
        const int nctx = lat ? 4 : 0, nT = nctx + (lt_hi - lt_lo + 1);
        const int h = hk * 4 + gq, qrow0 = rowbase + qb * 64 + half * 32;
        const float sink2 = inp(C, I_SINK)[l * 8 + h] * 1.4426950408889634f;
        bf16x8 Qf[2][2];
#pragma unroll
        for (int qt = 0; qt < 2; ++qt)
#pragma unroll
            for (int ds = 0; ds < 2; ++ds) Qf[qt][ds] = *(const bf16x8*)(MIX + (size_t)(qrow0 + qt * 16 + l15) * MIXW + h * 64 + ds * 32 + q4 * 8);
        f32x4 ot[4][2];
#pragma unroll
        for (int dt = 0; dt < 4; ++dt)
#pragma unroll
            for (int qt = 0; qt < 2; ++qt) ot[dt][qt] = (f32x4){0.f, 0.f, 0.f, 0.f};
        float mrun[2] = {sink2, sink2}, lrun[2] = {q4 == 0 ? 1.f : 0.f, q4 == 0 ? 1.f : 0.f};
        u32x4 kreg, vreg;
#define ATT_LOAD(tt) do { const int t_ = (tt); const bf16_t* kp; const bf16_t* vp; size_t vpitch; \
            if (t_ < nctx) { kp = KC + ((size_t)b * 256 + 64 * t_) * 128 + hk * 64; vp = VTC + (size_t)(b * 2 + hk) * 64 * 256 + 64 * t_; vpitch = 256; } \
            else { const int lt_ = lt_lo + (t_ - nctx); kp = KN + ((size_t)rowbase + 64 * lt_) * 128 + hk * 64; \
                   if (lat) { vp = VT + (size_t)MC * 128 + (size_t)(b * 2 + hk) * 64 * 2048 + 64 * lt_; vpitch = 2048; } else { vp = VT + (size_t)(b * 2 + hk) * 64 * 256 + 64 * lt_; vpitch = 256; } } \
            kreg = *(const u32x4*)(kp + (size_t)sr_ * 128 + sc_ * 8); vreg = *(const u32x4*)(vp + (size_t)sr_ * vpitch + sc_ * 8); } while (0)
        ATT_LOAD(0);
        for (int t = 0; t < nT; ++t) {
            *(LAS u32x4*)(Ks + sr_ * 144 + sc_ * 16) = kreg; *(LAS u32x4*)(Vs + sr_ * 144 + sc_ * 16) = vreg;
            __syncthreads();
            if (t + 1 < nT) ATT_LOAD(t + 1);
            f32x4 st[4][2];
#pragma unroll
            for (int kt = 0; kt < 4; ++kt) {
#pragma unroll
                for (int qt = 0; qt < 2; ++qt) st[kt][qt] = (f32x4){0.f, 0.f, 0.f, 0.f};
#pragma unroll
                for (int ds = 0; ds < 2; ++ds) { const bf16x8 Kf = *(const LAS bf16x8*)(Ks + (kt * 16 + l15) * 144 + (ds * 32 + q4 * 8) * 2);
#pragma unroll
                    for (int qt = 0; qt < 2; ++qt) st[kt][qt] = __builtin_amdgcn_mfma_f32_16x16x32_bf16(Kf, Qf[qt][ds], st[kt][qt], 0, 0, 0); } }
            int mtype = 0, ltile = 0; if (t >= nctx && lat) { ltile = lt_lo + (t - nctx); mtype = (ltile == qb - 2 || ltile == qb + 2) ? 1 : 0; }
            bf16x8 pb[2][2];
#pragma unroll
            for (int qt = 0; qt < 2; ++qt) {
                const int qp = qb * 64 + half * 32 + qt * 16 + l15;
                float mx = -INFINITY;
#pragma unroll
                for (int kt = 0; kt < 4; ++kt)
#pragma unroll
                    for (int i = 0; i < 4; ++i) { float tv = st[kt][qt][i] * SC;
                        if (mtype) { const int kp_ = ltile * 64 + kt * 16 + q4 * 4 + i; const int d = kp_ - qp; if (d > 128 || d < -128) tv = -INFINITY; }
                        st[kt][qt][i] = tv; mx = fmaxf(mx, tv); }
                mx = fmaxf(mx, shx(mx, 16, lane)); mx = fmaxf(mx, shx(mx, 32, lane));
                const float mnew = fmaxf(mrun[qt], mx), alpha = __builtin_amdgcn_exp2f(mrun[qt] - mnew); mrun[qt] = mnew;
                float ls = 0.f;
#pragma unroll
                for (int kt = 0; kt < 4; ++kt)
#pragma unroll
                    for (int i = 0; i < 4; ++i) { const float pv = __builtin_amdgcn_exp2f(st[kt][qt][i] - mnew); st[kt][qt][i] = pv; ls += pv; }
                lrun[qt] = lrun[qt] * alpha + ls;
#pragma unroll
                for (int dt = 0; dt < 4; ++dt) ot[dt][qt] = ot[dt][qt] * alpha;
#pragma unroll
                for (int ks = 0; ks < 2; ++ks) { const u32x4 w = pack8(st[2 * ks][qt], st[2 * ks + 1][qt]); pb[ks][qt] = __builtin_bit_cast(bf16x8, w); }
            }
#pragma unroll
            for (int ks = 0; ks < 2; ++ks)
#pragma unroll
                for (int dt = 0; dt < 4; ++dt) { const LAS unsigned char* vb = Vs + (dt * 16 + l15) * 144 + (32 * ks + q4 * 4) * 2;
                    const u32x2 v0 = *(const LAS u32x2*)vb, v1 = *(const LAS u32x2*)(vb + 32); const u32x4 vv = {v0.x, v0.y, v1.x, v1.y}; const bf16x8 Vf = __builtin_bit_cast(bf16x8, vv);
#pragma unroll
                    for (int qt = 0; qt < 2; ++qt) ot[dt][qt] = __builtin_amdgcn_mfma_f32_16x16x32_bf16(Vf, pb[ks][qt], ot[dt][qt], 0, 0, 0); }
            __syncthreads();
        }
#undef ATT_LOAD
#pragma unroll
        for (int qt = 0; qt < 2; ++qt) { float lsum = lrun[qt]; lsum += shx(lsum, 16, lane); lsum += shx(lsum, 32, lane); const float inv = 1.0f / lsum;
            bf16_t* op = dummy_out ? (bf16_t*)(C.ws + WS_XN) + (size_t)(qrow0 + qt * 16 + l15) * 1024 + h * 64 + q4 * 4 : MIX + (size_t)(qrow0 + qt * 16 + l15) * MIXW + h * 64 + q4 * 4;
#pragma unroll
            for (int dt = 0; dt < 4; ++dt) { const f32x4 o = ot[dt][qt] * inv; u32x2 w; w.x = cvt_pk_bf16(o[0], o[1]); w.y = cvt_pk_bf16(o[2], o[3]); *(u32x2*)(op + dt * 16) = w; } }
    }
}


#define XB_TMO      128
#define XB_XCNT(j)  (256  + 64 * (j))
#define XB_XSUB(j)  (1280 + 64 * (j))
#define XB_XGEN(j)  (2304 + 64 * (j))
#define XB_TOP      3328
#define XB_TOPGEN   3392
#define XCD_BAR_WORDS 3456
#define XB_SPIN_CAP (1u << 20)
__device__ __forceinline__ unsigned xb_ld(unsigned* p)              { return __hip_atomic_load(p, __ATOMIC_RELAXED, __HIP_MEMORY_SCOPE_AGENT); }
__device__ __forceinline__ unsigned xb_add(unsigned* p, unsigned v) { return __hip_atomic_fetch_add(p, v, __ATOMIC_RELAXED, __HIP_MEMORY_SCOPE_AGENT); }
__device__ __forceinline__ unsigned xb_xcc_id() { return (unsigned)__builtin_amdgcn_s_getreg((3 << 11) | 20) & 0xFu; }
#define XB_SPIN(cond, bar) do { unsigned _sp = 0; while (cond) { __builtin_amdgcn_s_sleep(1); \
    if ((++_sp & 255u) == 0u) { if (xb_ld(&(bar)[XB_TMO])) break; if (_sp > XB_SPIN_CAP) { atomicAdd(&(bar)[XB_TMO], 1u); break; } } } } while (0)
struct XcdBarrier { unsigned* bar; unsigned x; volatile LAS unsigned* st; };
__device__ __forceinline__ XcdBarrier xcd_barrier_post(unsigned* bar, volatile LAS unsigned* st, int tid) {
    XcdBarrier b; b.bar = bar; b.x = xb_xcc_id(); b.st = st;
    if (tid == 0) (void)xb_add(&bar[XB_XCNT(b.x)], 1u);
    return b;
}
__device__ __forceinline__ void xcd_barrier_complete(unsigned* bar, unsigned x, unsigned& nloc, unsigned& nx) {
    const unsigned G = gridDim.x * gridDim.y * gridDim.z;
    unsigned sum, cnt, mine, sp = 0u;
    for (;;) {
        sum = 0u; cnt = 0u; mine = 0u;
#pragma unroll
        for (unsigned j = 0; j < 16; ++j) { const unsigned c = xb_ld(&bar[XB_XCNT(j)]); sum += c; cnt += (c > 0u) ? 1u : 0u; mine = (j == x) ? c : mine; }
        if (sum == G) break;
        __builtin_amdgcn_s_sleep(1);
        if ((++sp & 255u) == 0u) { if (xb_ld(&bar[XB_TMO])) break; if (sp > XB_SPIN_CAP) { atomicAdd(&bar[XB_TMO], 1u); break; } }
    }
    nloc = mine > 0u ? mine : 1u; nx = cnt > 0u ? cnt : 1u;
}
__device__ __forceinline__ void xcd_barrier(const XcdBarrier& b, int tid) {
    asm volatile("s_waitcnt vmcnt(0)" ::: "memory");
    __syncthreads();
    if (tid == 0) {
        unsigned* bar = b.bar;
        __builtin_amdgcn_s_waitcnt(0);
        unsigned nloc = b.st[0], nx = b.st[1];
        if (nloc == 0u) { xcd_barrier_complete(bar, b.x, nloc, nx); b.st[0] = nloc; b.st[1] = nx; }
        const unsigned old = xb_add(&bar[XB_XSUB(b.x)], 1u);
        const unsigned gen = old / nloc;
        if (old + 1u == (gen + 1u) * nloc) {
            __builtin_amdgcn_fence(__ATOMIC_RELEASE, "agent");
            asm volatile("s_waitcnt vmcnt(0)" ::: "memory");
            const unsigned og = xb_add(&bar[XB_TOP], 1u);
            const unsigned tg = og / nx;
            if (og + 1u == (tg + 1u) * nx) xb_add(&bar[XB_TOPGEN], 1u);
            else XB_SPIN(xb_ld(&bar[XB_TOPGEN]) == tg, bar);
            __builtin_amdgcn_fence(__ATOMIC_ACQUIRE, "agent");
            xb_add(&bar[XB_XGEN(b.x)], 1u);
            asm volatile("s_waitcnt vmcnt(0)" ::: "memory");
        } else {
            XB_SPIN(xb_ld(&bar[XB_XGEN(b.x)]) == gen, bar);
            __builtin_amdgcn_fence(__ATOMIC_ACQUIRE, "agent");
            asm volatile("s_waitcnt vmcnt(0)" ::: "memory");
        }
    }
    __syncthreads();
}
#ifndef PROBE
#define PROBE 0
#endif
#define GSYNC() do { Ctx B_ = C; refresh(B_); xcd_barrier(xb, B_.tid); if (PROBE == 1) xcd_barrier(xb, B_.tid); } while (0)
#ifndef PHMASK
#define PHMASK 0xffff
#endif
#define PH(b) if constexpr ((PHMASK >> (b)) & 1)
template <int l> __device__ __forceinline__ void mix_block(Ctx& C, const XcdBarrier& xb) {
                PH(3) norm_phase(C, l, 1, 0);
                if (PROBE == 4) norm_phase(C, l, 1, 0);
                GSYNC();
                PH(5) { Ctx D = C; refresh(D); unsigned char* ws = D.ws; const int G = D.G, bx = D.bx; pg8::Sched S; S.init(ws + WS_XN, ws + WS_WINT + (size_t)l * 1280 * 1024 * 2, 96, 5, 1, (size_t)256 * 1024 * 2, (size_t)256 * 1024 * 2, 0, 0, G, bx);
                  pg8::EpiWin E{(bf16_t*)(ws + WS_MIX), (bf16_t*)(ws + WS_KVRAW), (bf16_t*)(ws + WS_UT), (bf16_t*)(ws + WS_AC)};
                  pg8::gemm_phase(D.lds, D.tid, 1024, 1024, 1024, S, E); }
                GSYNC();
                PH(6) qkv_prep(C, l, C.G >= 224 ? 112 : 0);
                PH(7) { Ctx D = C; refresh(D); unsigned char* ws = D.ws; const int G = D.G, bx = D.bx; pg8::Sched S; S.init(ws + WS_DFTC, ws + WS_UT, 2, 1, 32, (size_t)256 * 256 * 2, 0, 0, (size_t)256 * 256 * 2, G, bx);
                  pg8::EpiDFT<0> E{(bf16_t*)(ws + WS_MIX)}; pg8::gemm_phase(D.lds, D.tid, 256, 256, 256, S, E); }
                PH(8) { Ctx D = C; refresh(D); unsigned char* ws = D.ws; const int G = D.G, bx = D.bx; pg8::Sched S; S.init(ws + WS_AC, ws + WS_WAT + (size_t)l * 16 * 256 * 512 * 2, 3, 1, 16, (size_t)256 * 768 * 2, 0, (size_t)768 * 768 * 2, (size_t)256 * 512 * 2, G, (bx + G - 64 % G) % G);
                  pg8::EpiSsmA E{(float*)(ws + WS_SEND)}; pg8::gemm_phase(D.lds, D.tid, 768, 512, 512, S, E); }
                GSYNC();
                if (PROBE == 2) attn_phase(C, l, 1);
                PH(9) attn_phase(C, l);
                PH(10) carry_phase(C, l);
                if (PROBE == 8) carry_phase(C, l);
                GSYNC();
                PH(11) { Ctx D = C; refresh(D); unsigned char* ws = D.ws; const int G = D.G, bx = D.bx; pg8::Sched S; S.init(ws + WS_AC, ws + WS_MTT + (size_t)l * 16 * 512 * 768 * 2, 3, 2, 16, (size_t)256 * 768 * 2, (size_t)256 * 768 * 2, (size_t)768 * 768 * 2, (size_t)512 * 768 * 2, G, bx);
                  pg8::EpiSsmC E{(bf16_t*)(ws + WS_Y)}; pg8::gemm_phase(D.lds, D.tid, 768, 768, 768, S, E); if (PROBE == 8) pg8::gemm_phase(D.lds, D.tid, 768, 768, 768, S, E); }
                PH(7) { Ctx D = C; refresh(D); unsigned char* ws = D.ws; const int G = D.G, bx = D.bx; pg8::Sched S; S.init(ws + WS_DFTL, ws + WS_UT + (size_t)MC * 256 * 2, 8, 2, 8, (size_t)256 * 1024 * 2, (size_t)256 * 1024 * 2, 0, (size_t)512 * 1024 * 2, G, (bx + G - 96 % G) % G);
                  pg8::EpiDFT2 E{(bf16_t*)(ws + WS_MIX), (const f32x2*)(ws + WS_TWID)}; pg8::gemm_phase(D.lds, D.tid, 1024, 1024, 1024, S, E); }
                GSYNC();
                PH(12) { Ctx D = C; refresh(D); unsigned char* ws = D.ws; const int G = D.G, bx = D.bx; pg8::Sched S; S.init(ws + WS_Y, ws + WS_WGLUT + (size_t)l * 512 * 256 * 2, 96, 2, 1, (size_t)256 * 256 * 2, (size_t)256 * 256 * 2, 0, 0, G, bx);
                  pg8::EpiGated<1> E{(bf16_t*)(ws + WS_MIX) + 1024, MIXW}; pg8::gemm_phase(D.lds, D.tid, 256, 256, 256, S, E); if (PROBE == 8) pg8::gemm_phase(D.lds, D.tid, 256, 256, 256, S, E); }
                GSYNC();
                PH(13) { Ctx D = C; refresh(D); unsigned char* ws = D.ws; const int G = D.G, bx = D.bx; pg8::Sched S; S.init(ws + WS_MIX, ws + WS_WOUTT + (size_t)l * 1024 * 1280 * 2, 96, 4, 1, (size_t)256 * 1280 * 2, (size_t)256 * 1280 * 2, 0, 0, G, bx);
                  pg8::EpiResidT<2, 0> E{D.out, (const float*)(ws + WS_MOD) + (size_t)l * 9 * 9216 + 5 * 1024, D.out}; pg8::gemm_phase(D.lds, D.tid, 1280, 1280, 1280, S, E); }
                GSYNC();
                PH(3) norm_phase(C, l, 2, 0);
                if (PROBE == 4) norm_phase(C, l, 2, 0);
                GSYNC();
}
template <int l, int f> __device__ __forceinline__ void ffn_block(Ctx& C, const XcdBarrier& xb) {
    constexpr size_t W13 = WS_W13T + (size_t)(l * 2 + f) * 5632 * 1024 * 2, W2 = WS_W2T + (size_t)(l * 2 + f) * 1024 * 2816 * 2;
    constexpr size_t GOFF = (size_t)l * 9 * 9216 + (f == 0 ? 2 : 8) * 1024;
    PH(14) { Ctx D = C; refresh(D); unsigned char* ws = D.ws; const int G = D.G, bx = D.bx; pg8::Sched S; S.init(ws + WS_XN, ws + W13, 32, 22, 1, (size_t)256 * 1024 * 2, (size_t)256 * 1024 * 2, 0, 0, G, bx);
      pg8::EpiGated<0> E{(bf16_t*)(ws + WS_HID), FF}; pg8::gemm_phase(D.lds, D.tid, 1024, 1024, 1024, S, E); }
    if (f == 0) {
        Ctx D = C; refresh(D); unsigned char* ws = D.ws; const int G = D.G, bx = D.bx; pg8::Sched S; S.init(ws + WS_TW + (size_t)l * 512 * 256 * 2, ws + WS_WOFT + (size_t)l * 1024 * 256 * 2, 2, 4, 1, (size_t)256 * 256 * 2, (size_t)256 * 256 * 2, 0, 0, G, (bx + G - 192 % G) % G);
        pg8::EpiFold E{(bf16_t*)(ws + WS_WOUTT) + (size_t)l * 1024 * 1280}; pg8::gemm_phase(D.lds, D.tid, 256, 256, 256, S, E); }
    GSYNC();
    PH(15) { Ctx D = C; refresh(D); unsigned char* ws = D.ws; const int G = D.G, bx = D.bx, H = G / 2; pg8::Sched S; S.init(ws + WS_HID, ws + W2, 32, 4, 1, (size_t)256 * 2816 * 2, (size_t)256 * 2816 * 2, 0, 0, G, bx);
      S.range(0, 128, H, bx < H ? bx : -1, 0);
      pg8::EpiResidT<2, 1> E{D.out, (const float*)(ws + WS_MOD) + GOFF, (l == 0 && f == 0) ? inp(D, I_XP) : (const float*)D.out}; pg8::gemm_phase(D.lds, D.tid, 2816, 2816, 2816, S, E); }
    PH(14) { Ctx D = C; refresh(D); unsigned char* ws = D.ws; const int G = D.G, bx = D.bx, H = G / 2; pg8::Sched S; S.init(ws + WS_XN, ws + W13, 64, 22, 1, (size_t)256 * 1024 * 2, (size_t)256 * 1024 * 2, 0, 0, G, bx);
      if (bx < H) S.range(896, 1408, H, bx, 32); else S.range(0, 896, H, bx - H, 32);
      pg8::EpiGated<0> E{(bf16_t*)(ws + WS_HID), FF}; pg8::gemm_phase(D.lds, D.tid, 1024, 1024, 1024, S, E); }
    GSYNC();
    PH(15) { Ctx D = C; refresh(D); unsigned char* ws = D.ws; const int G = D.G, bx = D.bx; pg8::Sched S; S.init(ws + WS_HID, ws + W2, 64, 4, 1, (size_t)256 * 2816 * 2, (size_t)256 * 2816 * 2, 0, 0, G, bx);
      S.range(0, 256, G, bx, 32);
      pg8::EpiResidT<2, 1> E{D.out, (const float*)(ws + WS_MOD) + GOFF, (l == 0 && f == 0) ? inp(D, I_XS) - (size_t)MC * DM : (const float*)D.out}; pg8::gemm_phase(D.lds, D.tid, 2816, 2816, 2816, S, E); }
    if (l == 0 && f == 0) { p1_tables(C, 0); }
    GSYNC();
    if (l == 0 && f == 0) { p2_tables(C, 0); }
}
template <int l> __device__ __forceinline__ void layer_fwd(Ctx& C, const XcdBarrier& xb) {
    PH(3) norm_phase(C, l, 0, l == 0);
    if (PROBE == 4) norm_phase(C, l, 0, l == 0);
    GSYNC();
    ffn_block<l, 0>(C, xb);
    mix_block<l>(C, xb);
    ffn_block<l, 1>(C, xb);
}
__global__ void __launch_bounds__(512, 2) fwd_kernel(Args a) {
    extern __shared__ __attribute__((aligned(16))) unsigned char lds_raw[];
    cg::grid_group grid = cg::this_grid();
    Ctx C; C.out = a.out; C.ws = a.ws; C.wid0 = __builtin_amdgcn_readfirstlane((int)threadIdx.x >> 6);
    C.lds = (LAS unsigned char*)lds_raw;
    if (threadIdx.x == 0) {
#pragma unroll
        for (int i = 0; i < N_IN; ++i) *(const float* LAS*)(C.lds + PTR_OFF + i * 8) = a.in[i];
    }
    if (threadIdx.x < 2) *(volatile LAS unsigned*)(C.lds + PTR_OFF + 256 + threadIdx.x * 4) = 0u;
    if (blockIdx.x == 0) { for (int i = threadIdx.x; i < 3456; i += 512) ((unsigned*)(a.ws + WS_BAR))[i] = 0u; }
    __syncthreads();
    refresh(C);

    PH(0) p0_mod(C);
    PH(1) p0_weights(C, 0, 2, 0);
    PH(2) p0_tables(C);
    if (PROBE == 3) { p0_mod(C); p0_weights(C, 0, 1, 0); p0_tables(C); }
    grid.sync();
    XcdBarrier xb;
    { Ctx B_ = C; refresh(B_); xb = xcd_barrier_post((unsigned*)(B_.ws + WS_BAR), (volatile LAS unsigned*)(C.lds + PTR_OFF + 256), B_.tid); }

    layer_fwd<0>(C, xb);
    layer_fwd<1>(C, xb);
}

extern "C" void kernel_launch(void* const* d_in, const int* in_sizes, int n_in, void* d_out, int out_size, void* d_ws, size_t ws_size, hipStream_t stream) {
    static int grid = 0;
    if (grid == 0) {
        if (n_in != N_IN || ws_size < WS_TOTAL) { fprintf(stderr, "kernel_launch: need %d inputs and %zu bytes of workspace; got %d, %zu\n", (int)N_IN, (size_t)WS_TOTAL, n_in, ws_size); grid = -1; return; }
        int dev = 0, cus = 0, per_cu = 0;
        (void)hipGetDevice(&dev); (void)hipDeviceGetAttribute(&cus, hipDeviceAttributeMultiprocessorCount, dev);
        if (hipFuncSetAttribute((const void*)fwd_kernel, hipFuncAttributeMaxDynamicSharedMemorySize, LDS_BYTES) != hipSuccess) { fprintf(stderr, "kernel_launch: hipFuncSetAttribute failed\n"); grid = -1; return; }
        if (hipOccupancyMaxActiveBlocksPerMultiprocessor(&per_cu, (const void*)fwd_kernel, 512, LDS_BYTES) != hipSuccess || per_cu < 1) per_cu = 1;
        (void)hipGetLastError();
        grid = cus * per_cu;
        if (grid <= 0) { grid = -1; return; }
    }
    if (grid < 0) return;
    Args a{};
    for (int i = 0; i < N_IN; ++i) a.in[i] = (const float*)d_in[i];
    a.out = (float*)d_out; a.ws = (unsigned char*)d_ws;
    void* args[] = {&a};
    hipError_t e = hipLaunchCooperativeKernel((const void*)fwd_kernel, dim3(grid), dim3(512), args, LDS_BYTES, stream);
    if (e != hipSuccess) fprintf(stderr, "cooperative launch failed: %s (grid %d)\n", hipGetErrorString(e), grid);
}
```
